# Optimizing an MI355X kernel written in HIP

```python
import math
import jax, jax.numpy as jnp
from jax import lax
import numpy as np

D_MODEL = 2048
BATCH = 4
SEQ = 2048
DEPTH = 4

N_MIXERS = 3
D_INNER = D_MODEL
S5_GROUP = 16
S5_STATE = 64
S5_GROUPS = D_INNER // S5_GROUP
FOX_HEAD_DIM = 128
FOX_HEADS = D_INNER // FOX_HEAD_DIM
Q_BLOCK = 128
POOL_WINDOWS = (2, 4, 8, 16)
POOL_GROUPS = len(POOL_WINDOWS)
POOL_GROUP_DIM = D_INNER // POOL_GROUPS
N_S5 = (DEPTH + 2) // 3
N_FOX = (DEPTH + 1) // 3
N_POOL = DEPTH // 3
EPS = 1e-6
DT_MIN = 1e-3
DT_MAX = 1e-1

kernel_name = "hybrid_s5_fox_pool_interleaved"


def rmsnorm(x, w):
    xf = x.astype(jnp.float32)
    y = xf * lax.rsqrt(jnp.mean(xf * xf, axis=-1, keepdims=True) + EPS)
    return (y * w.astype(jnp.float32)).astype(x.dtype)


def _s5_combine(left, right):
    a1r, a1i, b1r, b1i = left
    a2r, a2i, b2r, b2i = right
    ar = a2r * a1r - a2i * a1i
    ai = a2r * a1i + a2i * a1r
    br = a2r * b1r - a2i * b1i + b2r
    bi = a2r * b1i + a2i * b1r + b2i
    return (ar, ai, br, bi)


def s5_mixer(u, a_re, a_im, log_dt, b_re, b_im, c_re, c_im, d_skip, w_glu, b_glu):
    f32 = jnp.float32
    bsz, L, E = u.shape
    ar = a_re.astype(f32)
    ai = a_im.astype(f32)
    dt = jnp.exp(log_dt.astype(f32))[:, None]
    mag = jnp.exp(ar * dt)
    abar_r = mag * jnp.cos(ai * dt)
    abar_i = mag * jnp.sin(ai * dt)
    den = ar * ar + ai * ai
    xr = abar_r - 1.0
    fr = (xr * ar + abar_i * ai) / den
    fi = (abar_i * ar - xr * ai) / den
    br = b_re.astype(f32)
    bi = b_im.astype(f32)
    bbar_r = fr[..., None] * br - fi[..., None] * bi
    bbar_i = fr[..., None] * bi + fi[..., None] * br
    ug = u.astype(f32).reshape(bsz, L, S5_GROUPS, S5_GROUP)
    bu_r = jnp.einsum('blgc,gpc->blgp', ug, bbar_r)
    bu_i = jnp.einsum('blgc,gpc->blgp', ug, bbar_i)
    a_r_el = jnp.broadcast_to(abar_r[None, None], (1, L, S5_GROUPS, S5_STATE))
    a_i_el = jnp.broadcast_to(abar_i[None, None], (1, L, S5_GROUPS, S5_STATE))
    _, _, h_r, h_i = lax.associative_scan(_s5_combine, (a_r_el, a_i_el, bu_r, bu_i), axis=1)
    y = (jnp.einsum('blgp,gcp->blgc', h_r, c_re.astype(f32))
         - jnp.einsum('blgp,gcp->blgc', h_i, c_im.astype(f32)))
    y = y.reshape(bsz, L, E) + d_skip.astype(f32) * u.astype(f32)
    g = jax.nn.gelu(y)
    y = g * jax.nn.sigmoid(g @ w_glu.astype(f32) + b_glu.astype(f32))
    return y.astype(u.dtype)


def fox_mixer(q, k, v, f_logit, q_norm_w, k_norm_w):
    f32 = jnp.float32
    bsz, L, H, Dh = q.shape
    q = rmsnorm(q, q_norm_w)
    k = rmsnorm(k, k_norm_w)
    cum = jnp.cumsum(jax.nn.log_sigmoid(f_logit.astype(f32)), axis=1)
    cum_k = cum.transpose(0, 2, 1)[:, :, None, :]
    scale = Dh ** -0.5
    nb = L // Q_BLOCK
    qb = q.reshape(bsz, nb, Q_BLOCK, H, Dh).transpose(1, 0, 2, 3, 4)
    cb = cum.reshape(bsz, nb, Q_BLOCK, H).transpose(1, 0, 2, 3)
    kpos = jnp.arange(L)

    def block(args):
        i, q_i, c_i = args
        s = jnp.einsum('bqhd,bkhd->bhqk', q_i, k).astype(f32) * scale
        s = s + c_i.transpose(0, 2, 1)[..., None] - cum_k
        qpos = i * Q_BLOCK + jnp.arange(Q_BLOCK)
        s = jnp.where(kpos[None, :] <= qpos[:, None], s, -jnp.inf)
        p = jax.nn.softmax(s, axis=-1)
        return jnp.einsum('bhqk,bkhd->bqhd', p.astype(v.dtype), v)

    out = lax.map(block, (jnp.arange(nb), qb, cb))
    return out.transpose(1, 0, 2, 3, 4).reshape(bsz, L, H * Dh)


def pool_mixer(u, w_group, layer_scale):
    f32 = jnp.float32
    bsz, L, E = u.shape
    uf = u.astype(f32)
    cs = jnp.concatenate([jnp.zeros((bsz, 1, E), f32), jnp.cumsum(uf, axis=1)], axis=1)
    t = jnp.arange(L)
    pooled = []
    for g, w in enumerate(POOL_WINDOWS):
        sl = slice(g * POOL_GROUP_DIM, (g + 1) * POOL_GROUP_DIM)
        lo = jnp.maximum(t + 1 - w, 0)
        s = cs[:, 1:, sl] - cs[:, lo, sl]
        cnt = jnp.minimum(t + 1, w).astype(f32)
        pooled.append(s / cnt[None, :, None])
    pooled = jnp.stack(pooled, axis=2)
    ug = uf.reshape(bsz, L, POOL_GROUPS, POOL_GROUP_DIM)
    mixed = jnp.einsum('blgc,gcd->blgd', pooled - ug, w_group.astype(f32))
    return (mixed.reshape(bsz, L, E) * layer_scale.astype(f32)).astype(u.dtype)


def setup_inputs(seed: int = 0) -> dict:
    key = jax.random.key(seed)
    ks = jax.random.split(key, 24)
    f32 = jnp.float32
    nrm = lambda k, shape, s: jax.random.normal(k, shape, f32) * s
    E, G, P, C = D_INNER, S5_GROUPS, S5_STATE, S5_GROUP
    x = nrm(ks[0], (BATCH, SEQ, D_MODEL), 1.0)
    norm_w = 1.0 + nrm(ks[1], (DEPTH, D_MODEL), 0.02)
    out_proj = nrm(ks[2], (DEPTH, E, D_MODEL), E ** -0.5 / math.sqrt(DEPTH))
    s5_in_proj = nrm(ks[3], (N_S5, D_MODEL, 2 * E), D_MODEL ** -0.5)
    n_idx = jnp.arange(P, dtype=f32)
    s5_a_re = -0.5 + nrm(ks[4], (N_S5, G, P), 0.01)
    s5_a_im = math.pi * n_idx[None, None, :] + nrm(ks[5], (N_S5, G, P), 0.01)
    s5_log_dt = jax.random.uniform(ks[6], (N_S5, G), f32, math.log(DT_MIN), math.log(DT_MAX))
    s5_b_re = nrm(ks[7], (N_S5, G, P, C), (2 * C) ** -0.5)
    s5_b_im = nrm(ks[8], (N_S5, G, P, C), (2 * C) ** -0.5)
    s5_c_re = nrm(ks[9], (N_S5, G, C, P), (2 * P) ** -0.5 * 2.0)
    s5_c_im = nrm(ks[10], (N_S5, G, C, P), (2 * P) ** -0.5 * 2.0)
    s5_d = nrm(ks[11], (N_S5, E), 1.0)
    s5_w_glu = nrm(ks[12], (N_S5, E, E), E ** -0.5)
    s5_b_glu = nrm(ks[13], (N_S5, E), 0.01)
    fox_in_proj = nrm(ks[14], (N_FOX, D_MODEL, 4 * E + FOX_HEADS), D_MODEL ** -0.5)
    fox_q_norm = 1.0 + nrm(ks[15], (N_FOX, FOX_HEAD_DIM), 0.02)
    fox_k_norm = 1.0 + nrm(ks[16], (N_FOX, FOX_HEAD_DIM), 0.02)
    fox_f_bias = jax.random.uniform(ks[17], (N_FOX, FOX_HEADS), f32, 1.0, 4.0)
    pool_in_proj = nrm(ks[18], (N_POOL, D_MODEL, 2 * E), D_MODEL ** -0.5)
    pool_w_group = nrm(ks[19], (N_POOL, POOL_GROUPS, POOL_GROUP_DIM, POOL_GROUP_DIM), POOL_GROUP_DIM ** -0.5)
    pool_scale = 1.0 + nrm(ks[20], (N_POOL, E), 0.1)
    return {"x": x, "norm_w": norm_w, "out_proj": out_proj,
            "s5_in_proj": s5_in_proj, "s5_a_re": s5_a_re, "s5_a_im": s5_a_im,
            "s5_log_dt": s5_log_dt, "s5_b_re": s5_b_re, "s5_b_im": s5_b_im,
            "s5_c_re": s5_c_re, "s5_c_im": s5_c_im, "s5_d": s5_d,
            "s5_w_glu": s5_w_glu, "s5_b_glu": s5_b_glu,
            "fox_in_proj": fox_in_proj, "fox_q_norm": fox_q_norm,
            "fox_k_norm": fox_k_norm, "fox_f_bias": fox_f_bias,
            "pool_in_proj": pool_in_proj, "pool_w_group": pool_w_group,
            "pool_scale": pool_scale}


def reference(x, norm_w, out_proj, s5_in_proj, s5_a_re, s5_a_im, s5_log_dt, s5_b_re, s5_b_im,
              s5_c_re, s5_c_im, s5_d, s5_w_glu, s5_b_glu, fox_in_proj, fox_q_norm, fox_k_norm,
              fox_f_bias, pool_in_proj, pool_w_group, pool_scale):
    E = D_INNER
    bsz, L, _ = x.shape
    h = x
    for i in range(DEPTH):
        kind = i % N_MIXERS
        j = i // N_MIXERS
        xn = rmsnorm(h, norm_w[i])
        if kind == 0:
            proj = xn @ s5_in_proj[j]
            u, z = proj[..., :E], proj[..., E:]
            y = s5_mixer(u, s5_a_re[j], s5_a_im[j], s5_log_dt[j], s5_b_re[j], s5_b_im[j],
                         s5_c_re[j], s5_c_im[j], s5_d[j], s5_w_glu[j], s5_b_glu[j])
        elif kind == 1:
            proj = xn @ fox_in_proj[j]
            hs = (bsz, L, FOX_HEADS, FOX_HEAD_DIM)
            q = proj[..., :E].reshape(hs)
            k = proj[..., E:2 * E].reshape(hs)
            v = proj[..., 2 * E:3 * E].reshape(hs)
            z = proj[..., 3 * E:4 * E]
            f_logit = proj[..., 4 * E:] + fox_f_bias[j]
            y = fox_mixer(q, k, v, f_logit, fox_q_norm[j], fox_k_norm[j])
        else:
            proj = xn @ pool_in_proj[j]
            u, z = proj[..., :E], proj[..., E:]
            y = pool_mixer(u, pool_w_group[j], pool_scale[j])
        h = h + (y * jax.nn.silu(z)) @ out_proj[i]
    return h
```

```cpp
#include <hip/hip_runtime.h>
#include <hip/hip_cooperative_groups.h>
#include <hip/hip_bf16.h>
#include <cstdio>
#include <cstdint>
namespace cg = cooperative_groups;
#ifndef PROBE_PH
#define PROBE_PH (-1)
#endif
#ifndef PROBE_NOEPI
#define PROBE_NOEPI 0
#endif
#ifndef PROBE_SYNC
#define PROBE_SYNC 0
#endif
#ifndef PROBE_NOFLOG
#define PROBE_NOFLOG 0
#endif
#ifndef RESID_MODE
#define RESID_MODE 0
#endif
#ifndef HALF_DELAY_TICKS
#define HALF_DELAY_TICKS 0
#endif
#ifndef DRAIN_ALL
#define DRAIN_ALL 1
#endif
#ifndef MK_MULTI
#define MK_MULTI 0
#endif
__device__ __forceinline__ int ltid() { int t = threadIdx.x; asm volatile("" : "+v"(t)); return t; }
__device__ __forceinline__ int lgrid() { int g = gridDim.x; asm volatile("" : "+s"(g)); return g; }
__device__ __forceinline__ int lbid() { int b = blockIdx.x; asm volatile("" : "+s"(b)); return b; }
namespace pg8 {
#define PG8_LAS __attribute__((address_space(3)))
typedef unsigned short bf16_t;
typedef short bf16x8 __attribute__((ext_vector_type(8)));
typedef float f32x4 __attribute__((ext_vector_type(4)));
typedef unsigned u32x4 __attribute__((ext_vector_type(4)));
constexpr int BM = 256, BK = 64, HALF = 128, HTB = HALF * BK * 2  , STAGE_BYTES = 8 * HTB, NXCD = 8, WGM = 8;

__host__ __device__ __forceinline__ int lds_byte(int r, int c) { const int st = (r >> 4) * 2 + (c >> 5), rr = r & 15, cc = c & 31, ob = rr * 64 + cc * 2; return st * 1024 + (ob ^ (((ob >> 9) & 1) << 5)); }
__host__ __device__ __forceinline__ void stage_rc(int b, int& R, int& C) { const int st = b / 1024, sb = b % 1024, swz = sb ^ (((sb >> 9) & 1) << 5); R = (st >> 1) * 16 + swz / 64; C = (st & 1) * 32 + (swz % 64) / 2; }
__host__ __device__ __forceinline__ int perm32(int rho) { const int n = rho >> 4, i = rho & 15; return 8 * (i >> 2) + 4 * n + (i & 3); }

struct Unit { int pm, pn; };
struct Gemm { const bf16_t* A; const bf16_t* Bt; int M, N, K, lda, grp; };

struct StaticOrder {
    int nM, nN, nwg, G, c, pmo, nx;
    __host__ __device__ void init(int M, int N, int G_, int c_, int pmo_ = 0, int nx_ = NXCD) { nM = M / BM; nN = N / BM; nwg = nM * nN; G = G_; c = c_; pmo = pmo_; nx = nx_; }
    __host__ __device__ bool next(int i, Unit& u) const {
        const long L = (long)i * G + c; if (L >= nwg) return false;
        int wgid = (int)L; { const int q = nwg / nx, r = nwg % nx, xcd = wgid % nx, off = wgid / nx; wgid = (xcd < r ? xcd * (q + 1) : r * (q + 1) + (xcd - r) * q) + off; }
        const int nig = WGM * nN, gid = wgid / nig, fm = gid * WGM, gsz = (nM - fm) < WGM ? (nM - fm) : WGM;
        u.pm = fm + ((wgid % nig) % gsz) + pmo; u.pn = (wgid % nig) / gsz; return true;
    }
    __device__ __forceinline__ void a_ready(const Unit&) const {}
    __device__ __forceinline__ void done(const Unit&) const {}
};

__device__ __forceinline__ unsigned cvt_pk_bf16(float lo, float hi) { unsigned r; asm volatile("v_cvt_pk_bf16_f32 %0, %1, %2" : "=v"(r) : "v"(lo), "v"(hi)); return r; }
typedef float f32x2 __attribute__((ext_vector_type(2)));
typedef unsigned u32x2 __attribute__((ext_vector_type(2)));
#ifndef EPI_RB
#define EPI_RB 8
#endif
#ifndef EPI_PREFETCH
#define EPI_PREFETCH 0
#endif
#ifndef EPI_NT
#define EPI_NT 0
#endif
#if EPI_NT
#define NTST(p, v) __builtin_nontemporal_store((v), (p))
#else
#define NTST(p, v) (*(p) = (v))
#endif
#ifndef EPI_WT
#define EPI_WT 1
#endif
#if 1
#endif
__device__ __forceinline__ float bf_lo(unsigned w) { return __uint_as_float(w << 16); }
__device__ __forceinline__ float bf_hi(unsigned w) { return __uint_as_float(w & 0xffff0000u); }
__device__ __forceinline__ float sigm_f(float v) { return __builtin_amdgcn_rcpf(1.f + __expf(-v)); }
__device__ __forceinline__ float silu_f(float v) { return v * sigm_f(v); }
__device__ __forceinline__ u32x4 pack8f(f32x4 a, f32x4 b) { u32x4 w; w.x = cvt_pk_bf16(a[0], a[1]); w.y = cvt_pk_bf16(a[2], a[3]); w.z = cvt_pk_bf16(b[0], b[1]); w.w = cvt_pk_bf16(b[2], b[3]); return w; }
__device__ __forceinline__ void unpack8f(u32x4 w, f32x4& a, f32x4& b) { a = (f32x4){bf_lo(w.x), bf_hi(w.x), bf_lo(w.y), bf_hi(w.y)}; b = (f32x4){bf_lo(w.z), bf_hi(w.z), bf_lo(w.w), bf_hi(w.w)}; }

enum { EM_UZ = 0, EM_QKVZ = 1, EM_GLU = 2, EM_POOL = 3, EM_OUT = 4 };
struct Epi {
    static constexpr bool PERM = true, AFTER_DRAIN = false;
    PG8_LAS float* xl; const float* qw; const float* kw;
    int mode; int drain;
    const float* ssq;
    bf16_t *o0, *o3;
    static constexpr size_t OSTR = (size_t)16 << 20;
    bf16_t* o3w;
    const bf16_t* gsrc;
    const float* vec;
    const float* hin; const bf16_t* hbin; const bf16_t* hlin; float* hout; bf16_t* hb; bf16_t* hl; float* ssq_out;
    __device__ __forceinline__ void operator()(const f32x4 (&acc)[2][2][4][2], const Unit& u, int wr, int wc, int fr, int fq) const {
        const int row0 = u.pm * BM + wr * 64 + fr;
        const int cw = wc * 32 + 8 * fq;
        if (mode == EM_UZ || mode == EM_QKVZ) {
            const int region = u.pn >> 3, ct = (u.pn & 7) * BM;
            const bool zreg = (mode == EM_UZ) ? (region == 1) : (region == 3);
            bf16_t* base = o0 + (size_t)(zreg ? 3 : region) * OSTR;
            const __amdgpu_buffer_rsrc_t wrs = __builtin_amdgcn_make_buffer_rsrc((void*)o0, (short)0, (int)(4 * OSTR * 2), 0x00020000);
            const unsigned wbase = (unsigned)((zreg ? 3 : region) * (OSTR * 2));
            const bool headmajor = (mode == EM_QKVZ) && !zreg;
            if (mode == EM_QKVZ && region < 2) {
                float rsv[2][4];
#pragma unroll
                for (int ai = 0; ai < 2; ++ai)
#pragma unroll
                    for (int m = 0; m < 4; ++m) {
                        const int row = row0 + ai * HALF + m * 16, rl = ai * HALF + wr * 64 + m * 16 + fr;
                        const f32x4 q0 = *(const f32x4*)(ssq + (size_t)row * 8), q1 = *(const f32x4*)(ssq + (size_t)row * 8 + 4);
                        const float rs = rsqrtf((((q0[0] + q0[1]) + (q0[2] + q0[3])) + ((q1[0] + q1[1]) + (q1[2] + q1[3]))) * (1.0f / 2048.0f) + 1e-6f);
                        rsv[ai][m] = rs;
#pragma unroll
                        for (int bj = 0; bj < 2; ++bj) { const f32x4 v0 = acc[ai][bj][m][0] * rs, v1 = acc[ai][bj][m][1] * rs;
                            float s = (v0[0] * v0[0] + v0[1] * v0[1]) + (v0[2] * v0[2] + v0[3] * v0[3]) + (v1[0] * v1[0] + v1[1] * v1[1]) + (v1[2] * v1[2] + v1[3] * v1[3]);
                            s += __shfl_xor(s, 16); s += __shfl_xor(s, 32);
                            if (fq == 0) xl[(rl * 2 + bj) * 4 + wc] = s; }
                    }
                asm volatile("s_waitcnt lgkmcnt(0)\n\ts_barrier" ::: "memory");
                const float* nw = qw + cw; const float* nk = kw + cw;
                f32x4 w0 = *(const f32x4*)nw, w1 = *(const f32x4*)(nw + 4); const f32x4 k0 = *(const f32x4*)nk, k1 = *(const f32x4*)(nk + 4);
                if (region == 1) { w0 = k0; w1 = k1; }
#pragma unroll
                for (int ai = 0; ai < 2; ++ai)
#pragma unroll
                    for (int m = 0; m < 4; ++m) {
                        const int row = row0 + ai * HALF + m * 16, rl = ai * HALF + wr * 64 + m * 16 + fr, b = row >> 11, tt = row & 2047;
#pragma unroll
                        for (int bj = 0; bj < 2; ++bj) { const f32x4 pp = *(const PG8_LAS f32x4*)(xl + (rl * 2 + bj) * 4);
                            const float rh = rsqrtf(((pp[0] + pp[1]) + (pp[2] + pp[3])) * (1.0f / 128.0f) + 1e-6f) * rsv[ai][m];
                            const f32x4 v0 = acc[ai][bj][m][0] * rh * w0, v1 = acc[ai][bj][m][1] * rh * w1;
                            const int head = (ct >> 7) + bj; const size_t off = ((size_t)((b * 16 + head) * 2048 + tt)) * 128 + cw;
                            *(u32x4*)(base + off) = pack8f(v0, v1); }
                    }
            } else
#pragma unroll
            for (int ai = 0; ai < 2; ++ai)
#pragma unroll
                for (int m = 0; m < 4; ++m) {
                    const int row = row0 + ai * HALF + m * 16;
                    const f32x4 q0 = *(const f32x4*)(ssq + (size_t)row * 8), q1 = *(const f32x4*)(ssq + (size_t)row * 8 + 4);
                    const float rs = rsqrtf((((q0[0] + q0[1]) + (q0[2] + q0[3])) + ((q1[0] + q1[1]) + (q1[2] + q1[3]))) * (1.0f / 2048.0f) + 1e-6f);
#pragma unroll
                    for (int bj = 0; bj < 2; ++bj) {
                        f32x4 v0 = acc[ai][bj][m][0] * rs, v1 = acc[ai][bj][m][1] * rs;
                        if (zreg) {
#pragma unroll
                            for (int e = 0; e < 4; ++e) { v0[e] = silu_f(v0[e]); v1[e] = silu_f(v1[e]); }
                        }
                        size_t off;
                        if (headmajor) { const int head = (ct >> 7) + bj, b = row >> 11, t = row & 2047; off = ((size_t)((b * 16 + head) * 2048 + t)) * 128 + cw; }
                        else off = (size_t)row * 2048 + ct + bj * HALF + cw;
                        if (EPI_WT == 2) __builtin_amdgcn_raw_buffer_store_b128(pack8f(v0, v1), wrs, wbase + (unsigned)(off * 2), 0, 16);
                        else NTST((u32x4*)(base + off), pack8f(v0, v1));
                    }
                }
        } else if (mode == EM_GLU || mode == EM_POOL) {
            const int col0 = u.pn * BM + cw;
            f32x4 bv[2][2];
#pragma unroll
            for (int bj = 0; bj < 2; ++bj) { bv[bj][0] = *(const f32x4*)(vec + col0 + bj * HALF); bv[bj][1] = *(const f32x4*)(vec + col0 + bj * HALF + 4); }
#pragma unroll
            for (int ai = 0; ai < 2; ++ai) {
                u32x4 sr[4][2], gr[4][2];
#pragma unroll
                for (int m = 0; m < 4; ++m)
#pragma unroll
                    for (int bj = 0; bj < 2; ++bj) { const size_t off = (size_t)(row0 + ai * HALF + m * 16) * 2048 + col0 + bj * HALF;
                        sr[m][bj] = *(const u32x4*)(o3 + off); if (mode == EM_GLU) gr[m][bj] = *(const u32x4*)(gsrc + off); else gr[m][bj] = (u32x4){0u, 0u, 0u, 0u}; }
#pragma unroll
                for (int m = 0; m < 4; ++m)
#pragma unroll
                    for (int bj = 0; bj < 2; ++bj) { const size_t off = (size_t)(row0 + ai * HALF + m * 16) * 2048 + col0 + bj * HALF;
                        f32x4 s0, s1; unpack8f(sr[m][bj], s0, s1);
                        f32x4 v0 = acc[ai][bj][m][0], v1 = acc[ai][bj][m][1];
                        if (mode == EM_GLU) { f32x4 g0, g1; unpack8f(gr[m][bj], g0, g1);
#pragma unroll
                            for (int e = 0; e < 4; ++e) { v0[e] = g0[e] * sigm_f(v0[e] + bv[bj][0][e]); v1[e] = g1[e] * sigm_f(v1[e] + bv[bj][1][e]); }
                        } else { v0 = v0 * bv[bj][0]; v1 = v1 * bv[bj][1]; }
                        *(u32x4*)(o3w + off) = pack8f(v0 * s0, v1 * s1); }
                asm volatile("" ::: "memory");
            }
        }
    }
    __device__ __forceinline__ void prefetch(const Unit& u, PG8_LAS unsigned char* lds, int wid, int lane) const {
        if (!EPI_PREFETCH || mode < EM_GLU) return;
        PG8_LAS unsigned* dump = (PG8_LAS unsigned*)(lds + 135168 + wid * 256);
        if (mode == EM_OUT) {
#pragma unroll
            for (int k = 0; k < 4; ++k) { const int li = wid * 256 + k * 64 + lane, r = li >> 3, l = li & 7;
                __builtin_amdgcn_global_load_lds((const unsigned*)(hin + (size_t)(u.pm * BM + r) * 2048 + u.pn * BM + l * 32), dump, 4, 0, 0); }
        } else {
#pragma unroll
            for (int k = 0; k < 2; ++k) { const int li = wid * 128 + k * 64 + lane, r = li >> 2, l = li & 3; const size_t off = (size_t)(u.pm * BM + r) * 2048 + u.pn * BM + l * 64;
                __builtin_amdgcn_global_load_lds((const unsigned*)(o3 + off), dump, 4, 0, 0);
                if (mode == EM_GLU) __builtin_amdgcn_global_load_lds((const unsigned*)(gsrc + off), dump, 4, 0, 0); }
        }
    }
    template <int ai>
    __device__ __forceinline__ void fused_half(const f32x4 (&acc)[2][2][4][2], const Unit& u, int wr, int wc, int fr, int fq, PG8_LAS float* T, int wid, int lane, const f32x4 bv) const {
        constexpr int LDW = 260, RB = EPI_RB;
        const int colw = wc * 32 + 8 * fq, rl0 = wr * 64 + fr, gcol = u.pn * BM + lane * 4;
        const size_t goff = (size_t)(u.pm * BM + ai * HALF + wid) * 2048 + gcol;
#pragma unroll
        for (int m = 0; m < 4; ++m)
#pragma unroll
            for (int bj = 0; bj < 2; ++bj) { PG8_LAS float* d = T + (rl0 + m * 16) * LDW + bj * HALF + colw; *(PG8_LAS f32x4*)d = acc[ai][bj][m][0]; *(PG8_LAS f32x4*)(d + 4) = acc[ai][bj][m][1]; }
        __syncthreads();
        for (int blk = 0; blk < 16 / RB; ++blk) {
            const size_t bo = goff + (size_t)blk * (8 * RB) * 2048;
            const PG8_LAS float* Tb = T + (wid + 8 * RB * blk) * LDW + lane * 4;
            if (mode == EM_OUT) {
                f32x4 hv[RB];
#pragma unroll
                for (int i = 0; i < RB; ++i) { if (hin) hv[i] = *(const f32x4*)(hin + bo + (size_t)i * 8 * 2048); else { const u32x2 r = *(const u32x2*)(hbin + bo + (size_t)i * 8 * 2048); hv[i] = (f32x4){bf_lo(r.x), bf_hi(r.x), bf_lo(r.y), bf_hi(r.y)};
                        if (hlin) { const u32x2 q = *(const u32x2*)(hlin + bo + (size_t)i * 8 * 2048); hv[i] = hv[i] + (f32x4){bf_lo(q.x), bf_hi(q.x), bf_lo(q.y), bf_hi(q.y)}; } } }
#pragma unroll
                for (int i = 0; i < RB; ++i) {
                    const f32x4 v = *(const PG8_LAS f32x4*)(Tb + 8 * i * LDW) + hv[i];
                    const size_t o = bo + (size_t)i * 8 * 2048;
                    if (hout) { if (EPI_WT) __builtin_amdgcn_raw_buffer_store_b128(__builtin_bit_cast(u32x4, v), __builtin_amdgcn_make_buffer_rsrc((void*)hout, (short)0, (int)(8192 * 2048 * 4), 0x00020000), (unsigned)(o * 4), 0, 16); else *(f32x4*)(hout + o) = v; }
                    if (hb) { u32x2 w; w.x = cvt_pk_bf16(v[0], v[1]); w.y = cvt_pk_bf16(v[2], v[3]); *(u32x2*)(hb + o) = w;
                        if (hl) { const f32x4 r = v - (f32x4){bf_lo(w.x), bf_hi(w.x), bf_lo(w.y), bf_hi(w.y)}; u32x2 wl; wl.x = cvt_pk_bf16(r[0], r[1]); wl.y = cvt_pk_bf16(r[2], r[3]); *(u32x2*)(hl + o) = wl; } }
                    if (ssq_out) { float s = (v[0] * v[0] + v[1] * v[1]) + (v[2] * v[2] + v[3] * v[3]);
#pragma unroll
                        for (int q = 1; q < 64; q <<= 1) s += __shfl_xor(s, q);
                        if (lane == 0) ssq_out[(size_t)(u.pm * BM + ai * HALF + wid + 8 * RB * blk + 8 * i) * 8 + u.pn] = s; }
                }
            } else {
                u32x2 sv[RB], gv[RB];
#pragma unroll
                for (int i = 0; i < RB; ++i) { sv[i] = *(const u32x2*)(o3 + bo + (size_t)i * 8 * 2048); gv[i] = (mode == EM_GLU) ? *(const u32x2*)(gsrc + bo + (size_t)i * 8 * 2048) : (u32x2){0u, 0u}; }
#pragma unroll
                for (int i = 0; i < RB; ++i) {
                    f32x4 v = *(const PG8_LAS f32x4*)(Tb + 8 * i * LDW);
                    const f32x4 s4 = {bf_lo(sv[i].x), bf_hi(sv[i].x), bf_lo(sv[i].y), bf_hi(sv[i].y)};
                    if (mode == EM_GLU) { const f32x4 g4 = {bf_lo(gv[i].x), bf_hi(gv[i].x), bf_lo(gv[i].y), bf_hi(gv[i].y)};
#pragma unroll
                        for (int q = 0; q < 4; ++q) v[q] = g4[q] * sigm_f(v[q] + bv[q]);
                    } else v = v * bv;
                    v = v * s4;
                    u32x2 w; w.x = cvt_pk_bf16(v[0], v[1]); w.y = cvt_pk_bf16(v[2], v[3]); *(u32x2*)(o3w + bo + (size_t)i * 8 * 2048) = w;
                }
            }
        }
        __syncthreads();
    }
    __device__ __forceinline__ void fused(const f32x4 (&acc)[2][2][4][2], const Unit& u, int wr, int wc, int fr, int fq, PG8_LAS unsigned char* lds, int wid, int lane) const {
        f32x4 bv = {0.f, 0.f, 0.f, 0.f};
        if (mode != EM_OUT) bv = *(const f32x4*)(vec + u.pn * BM + lane * 4);
        fused_half<0>(acc, u, wr, wc, fr, fq, (PG8_LAS float*)lds, wid, lane, bv);
        fused_half<1>(acc, u, wr, wc, fr, fq, (PG8_LAS float*)lds, wid, lane, bv);
    }
};
template <class Epi, class Sched, bool ALIGN_EPI = false, bool SP2 = false>
__device__ __forceinline__ void gemm_phase(PG8_LAS unsigned char* lds, const Gemm g, const Sched S, const Epi E) {
    const int tid = ltid(), wid = __builtin_amdgcn_readfirstlane(tid >> 6), lane = tid & 63, wr = wid >> 2, wc = wid & 3, fr = lane & 15, fq = lane >> 4;
    const int K = g.K, nt = K / BK;
    unsigned voffA[2], voffB[2];
#pragma unroll
    for (int i = 0; i < 2; ++i) { int R, C; stage_rc(tid * 16 + i * 8192, R, C); const int Rb = Epi::PERM ? ((R & ~31) + perm32(R & 31)) : R;
        voffA[i] = (unsigned)(R * g.lda + C) * 2u; voffB[i] = (unsigned)(Rb * K + C) * 2u; }
    const size_t kstep = (size_t)(BK * 2);
    const size_t hstepA = (size_t)HALF * g.lda * 2, hstepB = (size_t)HALF * K * 2;
    const size_t tstepA = 2 * hstepA, tstepB = 2 * hstepB;
#define PG8_GOFF(pn_) (g.grp ? (size_t)((pn_) / g.grp) * (size_t)K * 2 : (size_t)0)
    const unsigned ldsw = (unsigned)wid * 1024u;
    const int aoff = lds_byte(wr * 64 + fr, fq * 8), boff = lds_byte(wc * 32 + fr, fq * 8);
#define PG8_SA(b, h) (((b) * 2 + (h)) * HTB)
#define PG8_SB(b, h) ((4 + (b) * 2 + (h)) * HTB)
#define PG8_STAGE(bufoff, gbase, voff) do { _Pragma("unroll") for (int _i = 0; _i < 2; ++_i) \
        __builtin_amdgcn_global_load_lds((const unsigned*)((const char*)(gbase) + (voff)[_i]), (PG8_LAS unsigned*)(lds + (bufoff) + ldsw + _i * 8192), 16, 0, 0); } while (0)
#define PG8_LDA(dst, b, h) do { _Pragma("unroll") for (int m = 0; m < 4; ++m) _Pragma("unroll") for (int k = 0; k < 2; ++k) dst[m][k] = *(const PG8_LAS bf16x8*)(lds + PG8_SA(b, h) + aoff + m * 2048 + k * 1024); } while (0)
#define PG8_LDB(dst, b, h) do { _Pragma("unroll") for (int n = 0; n < 2; ++n) _Pragma("unroll") for (int k = 0; k < 2; ++k) dst[n][k] = *(const PG8_LAS bf16x8*)(lds + PG8_SB(b, h) + boff + n * 2048 + k * 1024); } while (0)
#define PG8_MMA(ai, bj, At, Bt) do { __builtin_amdgcn_s_setprio(1); _Pragma("unroll") for (int m = 0; m < 4; ++m) _Pragma("unroll") for (int n = 0; n < 2; ++n) _Pragma("unroll") for (int k = 0; k < 2; ++k) \
        acc[ai][bj][m][n] = __builtin_amdgcn_mfma_f32_16x16x32_bf16(Bt[n][k], At[m][k], acc[ai][bj][m][n], 0, 0, 0); __builtin_amdgcn_s_setprio(0); } while (0)
#define PG8_WAIT_V(n) asm volatile("s_waitcnt vmcnt(" #n ")" ::: "memory")
#define PG8_WAIT_L(n) asm volatile("s_waitcnt lgkmcnt(" #n ")" ::: "memory")
#define PG8_BAR __builtin_amdgcn_s_barrier()
#define PG8_SCHED __builtin_amdgcn_sched_barrier(0)
    Unit cur, nxt; int ui = 0;
    if (!S.next(0, cur)) return;
    f32x4 acc[2][2][4][2];
#pragma unroll
    for (int a = 0; a < 2; ++a)
#pragma unroll
        for (int b = 0; b < 2; ++b)
#pragma unroll
            for (int m = 0; m < 4; ++m)
#pragma unroll
                for (int n = 0; n < 2; ++n) acc[a][b][m][n] = (f32x4){0.f, 0.f, 0.f, 0.f};
    bf16x8 At[4][2], B0[2][2], B1[2][2];
    const char* cA = (const char*)g.A + (size_t)cur.pm * tstepA + PG8_GOFF(cur.pn); const char* cB = (const char*)g.Bt + (size_t)cur.pn * tstepB;
    S.a_ready(cur);
    E.prefetch(cur, lds, wid, lane);
    if constexpr (SP2) {
        PG8_STAGE(PG8_SB(0, 0), cB, voffB); PG8_STAGE(PG8_SB(0, 1), cB + hstepB, voffB); PG8_STAGE(PG8_SA(0, 0), cA, voffA); PG8_STAGE(PG8_SA(0, 1), cA + hstepA, voffA);
        if (wr == 1) PG8_BAR;
        PG8_WAIT_V(2); PG8_BAR;
        PG8_STAGE(PG8_SB(1, 0), cB + kstep, voffB); PG8_STAGE(PG8_SA(1, 0), cA + kstep, voffA); PG8_STAGE(PG8_SB(1, 1), cB + hstepB + kstep, voffB);
        PG8_WAIT_V(6); PG8_BAR;
    } else {
        PG8_STAGE(PG8_SB(0, 0), cB, voffB); PG8_STAGE(PG8_SA(0, 0), cA, voffA); PG8_STAGE(PG8_SB(0, 1), cB + hstepB, voffB); PG8_STAGE(PG8_SA(0, 1), cA + hstepA, voffA);
        if (wr == 1) PG8_BAR;
        PG8_WAIT_V(4); PG8_BAR;
        PG8_STAGE(PG8_SB(1, 0), cB + kstep, voffB); PG8_STAGE(PG8_SA(1, 0), cA + kstep, voffA); PG8_STAGE(PG8_SB(1, 1), cB + hstepB + kstep, voffB);
        PG8_WAIT_V(6); PG8_BAR;
    }
    for (;;) {
        const bool has_next = S.next(ui + 1, nxt);
        const char* nA = has_next ? (const char*)g.A + (size_t)nxt.pm * tstepA + PG8_GOFF(nxt.pn) : cA; const char* nB = has_next ? (const char*)g.Bt + (size_t)nxt.pn * tstepB : cB;
        for (int t = 0; t < nt; t += 2) {
            const bool last = (t == nt - 2);
            const char* a1 = cA + (size_t)(t + 1) * kstep;
            const char* a2 = last ? nA : cA + (size_t)(t + 2) * kstep; const char* b2 = last ? nB : cB + (size_t)(t + 2) * kstep;
            const char* a3 = a2 + kstep; const char* b3 = b2 + kstep;
            if (last && has_next) S.a_ready(nxt);
            if constexpr (SP2) {
            PG8_LDB(B0, 0, 0); PG8_LDB(B1, 0, 1); PG8_SCHED; PG8_LDA(At, 0, 0); PG8_STAGE(PG8_SA(1, 1), a1 + hstepA, voffA);
            PG8_WAIT_V(8); PG8_WAIT_L(0); PG8_BAR; PG8_MMA(0, 0, At, B0); PG8_MMA(0, 1, At, B1); PG8_BAR; PG8_SCHED;
            PG8_LDA(At, 0, 1); PG8_STAGE(PG8_SB(0, 0), b2, voffB); PG8_STAGE(PG8_SB(0, 1), b2 + hstepB, voffB); PG8_STAGE(PG8_SA(0, 0), a2, voffA);
            PG8_WAIT_V(8); PG8_WAIT_L(0); PG8_BAR; PG8_MMA(1, 0, At, B0); PG8_MMA(1, 1, At, B1); PG8_BAR; PG8_SCHED;
            PG8_LDB(B0, 1, 0); PG8_LDB(B1, 1, 1); PG8_SCHED; PG8_LDA(At, 1, 0); PG8_STAGE(PG8_SA(0, 1), a2 + hstepA, voffA);
            PG8_WAIT_V(8); PG8_WAIT_L(0); PG8_BAR; PG8_MMA(0, 0, At, B0); PG8_MMA(0, 1, At, B1); PG8_BAR; PG8_SCHED;
            PG8_LDA(At, 1, 1); PG8_STAGE(PG8_SB(1, 0), b3, voffB); PG8_STAGE(PG8_SB(1, 1), b3 + hstepB, voffB); PG8_STAGE(PG8_SA(1, 0), a3, voffA);
            PG8_WAIT_V(8); PG8_WAIT_L(0); PG8_BAR; PG8_MMA(1, 0, At, B0); PG8_MMA(1, 1, At, B1); PG8_BAR; PG8_SCHED;
            } else {
            PG8_LDB(B0, 0, 0); PG8_SCHED; PG8_LDA(At, 0, 0); PG8_STAGE(PG8_SA(1, 1), a1 + hstepA, voffA);
            PG8_WAIT_L(8); PG8_BAR; PG8_WAIT_L(0); PG8_MMA(0, 0, At, B0); PG8_BAR; PG8_SCHED;
            PG8_LDB(B1, 0, 1); PG8_STAGE(PG8_SB(0, 0), b2, voffB);
            PG8_BAR; PG8_WAIT_L(0); PG8_MMA(0, 1, At, B1); PG8_BAR;
            PG8_LDA(At, 0, 1); PG8_STAGE(PG8_SA(0, 0), a2, voffA);
            PG8_BAR; PG8_WAIT_L(0); PG8_MMA(1, 0, At, B0); PG8_BAR; PG8_SCHED;
            PG8_STAGE(PG8_SB(0, 1), b2 + hstepB, voffB);
            PG8_WAIT_V(6); PG8_BAR; PG8_MMA(1, 1, At, B1); PG8_BAR;
            PG8_LDB(B0, 1, 0); PG8_SCHED; PG8_LDA(At, 1, 0); PG8_STAGE(PG8_SA(0, 1), a2 + hstepA, voffA);
            PG8_WAIT_L(8); PG8_BAR; PG8_WAIT_L(0); PG8_MMA(0, 0, At, B0); PG8_BAR; PG8_SCHED;
            PG8_LDB(B1, 1, 1); PG8_STAGE(PG8_SB(1, 0), b3, voffB);
            PG8_BAR; PG8_WAIT_L(0); PG8_MMA(0, 1, At, B1); PG8_BAR;
            PG8_LDA(At, 1, 1); PG8_STAGE(PG8_SA(1, 0), a3, voffA);
            PG8_BAR; PG8_WAIT_L(0); PG8_MMA(1, 0, At, B0); PG8_BAR; PG8_SCHED;
            PG8_STAGE(PG8_SB(1, 1), b3 + hstepB, voffB);
            PG8_WAIT_V(6); PG8_BAR; PG8_MMA(1, 1, At, B1); PG8_BAR;
            }
        }
        if constexpr (ALIGN_EPI) { if (wr == 0) PG8_BAR; }
        if (!E.drain) { const int l2 = ltid() & 63; E(acc, cur, wr, wc, l2 & 15, l2 >> 4); S.done(cur); }
        if (!has_next) break;
#pragma unroll
        for (int a = 0; a < 2; ++a)
#pragma unroll
            for (int b = 0; b < 2; ++b)
#pragma unroll
                for (int m = 0; m < 4; ++m)
#pragma unroll
                    for (int n = 0; n < 2; ++n) acc[a][b][m][n] = (f32x4){0.f, 0.f, 0.f, 0.f};
        cur = nxt; cA = nA; cB = nB; ++ui;
        if constexpr (ALIGN_EPI) { if (wr == 1) PG8_BAR; }
    }
    PG8_WAIT_V(0);
    if constexpr (!ALIGN_EPI) { if (wr == 0) PG8_BAR; }
    PG8_BAR;
    if (E.drain) { const int l2 = ltid() & 63; E.fused(acc, cur, wr, wc, l2 & 15, l2 >> 4, lds, wid, l2); S.done(cur); }
#undef PG8_GOFF
#undef PG8_SA
#undef PG8_SB
#undef PG8_STAGE
#undef PG8_LDA
#undef PG8_LDB
#undef PG8_MMA
#undef PG8_WAIT_V
#undef PG8_WAIT_L
#undef PG8_BAR
#undef PG8_SCHED
}
}
namespace att {
enum { ORDER_NATURAL = 0, ORDER_REVERSED = 1, ORDER_PAIRED = 2, ORDER_XCD = 4 };
constexpr int B = 4, H = 16, HKV = 16, SQ = 2048, SKV = 2048, D = 128;
constexpr int QOFF = 0;
constexpr int WINDOW = SKV;
constexpr float THR = 8.f;
constexpr bool WSKIP = false;
constexpr float SCALE = 0.08838834764831845f;
constexpr int NW = 8, QBLK = 32, KVBLK = 64, QB = NW * QBLK;
constexpr int SHM_V = KVBLK * D * 2, SHM_K = KVBLK * D * 2;
constexpr int CS_OFF = 2 * SHM_V + 2 * SHM_K + NW * 64 * 4;
constexpr int QS_OFF = CS_OFF + SKV * 4;
constexpr int LDS_BYTES = QS_OFF + NW * 8192;
constexpr int OLD = 2048;
#ifndef ATT_QREG
#define ATT_QREG 8
#endif
constexpr int QREG = ATT_QREG;
static_assert(D == 128 && SQ % QB == 0 && SKV % KVBLK == 0 && H % HKV == 0 && QOFF >= 0 && QOFF + SQ <= SKV && WINDOW >= 1, "geometry");

using bf16 = __hip_bfloat16;
typedef short bf16x8 __attribute__((ext_vector_type(8)));
typedef short s16x4 __attribute__((ext_vector_type(4)));
typedef float f32x16 __attribute__((ext_vector_type(16)));
typedef float f32x4 __attribute__((ext_vector_type(4)));
typedef unsigned u32x4 __attribute__((ext_vector_type(4)));
template <class A, class Bt> struct same_t { static constexpr bool v = false; };
template <class A> struct same_t<A, A> { static constexpr bool v = true; };

#define LDSA __attribute__((address_space(3)))
typedef LDSA char lchar;
#define KSWZ(row, colB) ((row) * 256 + ((colB) ^ (((row) & 7) << 4)))
#define SBAR() __builtin_amdgcn_sched_barrier(0)
__device__ __forceinline__ int v_st(int k, int c) { const int kk = (k & ~0xC) | ((k & 4) << 1) | ((k & 8) >> 1); return ((kk >> 3) * 4 + (c >> 5)) * 512 + ((kk & 7) * 32 + (c & 31)) * 2; }
__device__ __forceinline__ int v_rd_base(int lane) { return ((lane & 3) << 3) | (((lane >> 2) & 3) << 6) | (((lane >> 4) & 1) << 5) | (((lane >> 5) & 1) << 8); }
constexpr int v_rd_off(int d0, int ks, int half) { return d0 * 512 + ks * 4096 + half * 2048; }
__device__ __forceinline__ int crow(int r, int hi) { return (r & 3) + 8 * (r >> 2) + 4 * hi; }
__device__ __forceinline__ unsigned cvtpk(float lo, float hi) {
    unsigned r; asm volatile("v_cvt_pk_bf16_f32 %0, %1, %2" : "=v"(r) : "v"(lo), "v"(hi)); return r;
}
__device__ __forceinline__ bf16x8 pack8(f32x4 a, f32x4 b) {
    u32x4 w = {cvtpk(a[0], a[1]), cvtpk(a[2], a[3]), cvtpk(b[0], b[1]), cvtpk(b[2], b[3])};
    return *reinterpret_cast<bf16x8*>(&w);
}
template <class T> __device__ __forceinline__ bf16x8 load8(const T* p) {
    if constexpr (same_t<T, float>::v) { return pack8(*(const f32x4*)p, *(const f32x4*)(p + 4)); }
    else { return *reinterpret_cast<const bf16x8*>(p); }
}
__device__ __forceinline__ void mask_tile(f32x16& p0, f32x16& p1, int dq, unsigned W) {
    const float NEG = -__builtin_inff();
#pragma unroll
    for (int r = 0; r < 16; ++r) {
        const int c = (r & 3) + 8 * (r >> 2);
        if ((unsigned)(dq - c) >= W) p0[r] = NEG;
        if ((unsigned)(dq - c - 32) >= W) p1[r] = NEG;
    }
}
__device__ __forceinline__ void partialSM(f32x16& p0, f32x16& p1, float& m_reg, float& mn, float& alpha) {
    float pmax = p0[0]; for (int r = 1; r < 16; ++r) pmax = fmaxf(pmax, p0[r]); for (int r = 0; r < 16; ++r) pmax = fmaxf(pmax, p1[r]);
    { auto rr = __builtin_amdgcn_permlane32_swap(__float_as_uint(pmax), __float_as_uint(pmax), false, false);
      pmax = fmaxf(__uint_as_float(rr[0]), __uint_as_float(rr[1])); }
    constexpr float C2 = 1.4426950408889634f * SCALE;
    if (__builtin_expect(__all((pmax - m_reg) * SCALE <= THR), 1)) { mn = m_reg; alpha = 1.f; }
    else { mn = fmaxf(m_reg, pmax); alpha = __builtin_amdgcn_exp2f((m_reg - mn) * C2); m_reg = mn; }
    const float mnL = -mn * C2;
    for (int r = 0; r < 16; ++r) p0[r] = fmaf(p0[r], C2, mnL); for (int r = 0; r < 16; ++r) p1[r] = fmaf(p1[r], C2, mnL);
    for (int r = 0; r < 16; ++r) p0[r] = __builtin_amdgcn_exp2f(p0[r]);
}
__device__ __forceinline__ void finishSM(f32x16& p0, f32x16& p1, float alpha, float& l_reg, bf16x8& pa0, bf16x8& pa1, bf16x8& pa2, bf16x8& pa3) {
    for (int r = 0; r < 16; ++r) p1[r] = __builtin_amdgcn_exp2f(p1[r]);
    float ps = 0; for (int r = 0; r < 16; ++r) ps += p0[r]; for (int r = 0; r < 16; ++r) ps += p1[r];
    { auto rr = __builtin_amdgcn_permlane32_swap(__float_as_uint(ps), __float_as_uint(ps), false, false);
      ps = __uint_as_float(rr[0]) + __uint_as_float(rr[1]); }
    l_reg = l_reg * alpha + ps;
#define PK4(P, B_, OUT) do { unsigned a0 = cvtpk(P[B_+0], P[B_+1]), a1 = cvtpk(P[B_+2], P[B_+3]);                          \
        unsigned b0 = cvtpk(P[B_+4], P[B_+5]), b1 = cvtpk(P[B_+6], P[B_+7]);                                             \
        auto r0 = __builtin_amdgcn_permlane32_swap(a0, b0, false, false); auto r1 = __builtin_amdgcn_permlane32_swap(a1, b1, false, false); \
        u32x4 w = {r0[0], r1[0], r0[1], r1[1]}; OUT = *reinterpret_cast<bf16x8*>(&w); } while (0)
    PK4(p0, 0, pa0); PK4(p0, 8, pa1); PK4(p1, 0, pa2); PK4(p1, 8, pa3);
#undef PK4
}
template <int KB, bool SK>
__device__ __forceinline__ void qkt(f32x16& p0, f32x16& p1, const lchar* K_lds, int r32, int hi, const lchar* qsl, const bf16x8* qh, bool act, const lchar* csb, float cqs) {
    if (SK && !act) { const float NEG = -__builtin_inff();
#pragma unroll
        for (int r = 0; r < 16; ++r) { p0[r] = NEG; p1[r] = NEG; } return; }
    { const LDSA f32x4* cb = (const LDSA f32x4*)csb;
#pragma unroll
      for (int j = 0; j < 4; ++j) { const f32x4 a = cb[2 * j], b = cb[2 * j + 8];
#pragma unroll
          for (int e = 0; e < 4; ++e) { p0[4 * j + e] = cqs - a[e]; p1[4 * j + e] = cqs - b[e]; } } }
    const lchar* kb[4];
#pragma unroll
    for (int dd = 0; dd < 4; ++dd) kb[dd] = K_lds + KB * SHM_K + KSWZ(r32, (dd * 16 + hi * 8) * 2);
#pragma unroll
    for (int d0 = 0; d0 < 8; ++d0) { const lchar* a = kb[d0 & 3] + (d0 >> 2) * 128;
        bf16x8 b0 = *(const LDSA bf16x8*)(a);
        bf16x8 b1 = *(const LDSA bf16x8*)(a + 32 * 256);
        const bf16x8 qf = (d0 < QREG) ? qh[d0] : *(const LDSA bf16x8*)(qsl + d0 * 1024);
        p0 = __builtin_amdgcn_mfma_f32_32x32x16_bf16(b0, qf, p0, 0, 0, 0);
        p1 = __builtin_amdgcn_mfma_f32_32x32x16_bf16(b1, qf, p1, 0, 0, 0); }
}
template <int VB, bool SK>
__device__ __forceinline__ void pv_tile(f32x16* o, int vb0, bf16x8 pa0, bf16x8 pa1, bf16x8 pa2, bf16x8 pa3, bool act) {
    if (SK && !act) return;
#define TRRD(dst, off) asm volatile("ds_read_b64_tr_b16 %0, %1 offset:%2" : "=&v"(dst) : "v"(vb0), "i"(off) : "memory")
#define PV_D0(d0) do { s16x4 l0, l1, l2, l3, h0, h1, h2, h3; constexpr int b_ = VB * SHM_V + v_rd_off(d0, 0, 0);     \
        TRRD(l0, b_); TRRD(h0, b_ + 2048); TRRD(l1, b_ + 4096); TRRD(h1, b_ + 6144); TRRD(l2, b_ + 8192); TRRD(h2, b_ + 10240); TRRD(l3, b_ + 12288); TRRD(h3, b_ + 14336); \
        asm volatile("s_waitcnt lgkmcnt(0)" ::: "memory"); SBAR();                 \
        o[d0] = __builtin_amdgcn_mfma_f32_32x32x16_bf16(pa0, (bf16x8){l0[0], l0[1], l0[2], l0[3], h0[0], h0[1], h0[2], h0[3]}, o[d0], 0, 0, 0);   \
        o[d0] = __builtin_amdgcn_mfma_f32_32x32x16_bf16(pa1, (bf16x8){l1[0], l1[1], l1[2], l1[3], h1[0], h1[1], h1[2], h1[3]}, o[d0], 0, 0, 0);   \
        o[d0] = __builtin_amdgcn_mfma_f32_32x32x16_bf16(pa2, (bf16x8){l2[0], l2[1], l2[2], l2[3], h2[0], h2[1], h2[2], h2[3]}, o[d0], 0, 0, 0);   \
        o[d0] = __builtin_amdgcn_mfma_f32_32x32x16_bf16(pa3, (bf16x8){l3[0], l3[1], l3[2], l3[3], h3[0], h3[1], h3[2], h3[3]}, o[d0], 0, 0, 0); } while (0)
    PV_D0(0); PV_D0(1); PV_D0(2); PV_D0(3);
#undef PV_D0
#undef TRRD
}

template <class TIn, class TOut> struct BlockRef { const TIn* Q; const TIn* K; const TIn* V; TOut* O; const TOut* OI; const float* CS; int P0; };
template <class TIn> struct Seam {
    bf16x8 qr[8];
    bf16x8 st_v0, st_v1, st_k0, st_k1; f32x4 sf0, sf1, sf2, sf3;
    f32x4 tq[16];
    f32x4 csv;
};
__device__ __forceinline__ int swa_jlo(int P0, int W) { const int lowk = P0 - W + 1; return lowk > 0 ? lowk / KVBLK : 0; }
__device__ __forceinline__ int swa_jhi(int P0, int skv) { int j = (P0 + QB - 1) / KVBLK + 1; return j > skv / KVBLK ? skv / KVBLK : j; }
#define ROW(p, k0, rr) ((p) + (size_t)((k0) + (rr)) * D + sc)
#define VMW() asm volatile("s_waitcnt vmcnt(0)" ::: "memory")
#define VMWN(n) asm volatile("s_waitcnt vmcnt(%0)" :: "i"(n) : "memory")
#define SLOAD_H(Kp, Vp, k0) do { S.st_v0 = load8<TIn>(ROW(Vp, k0, sr)); S.st_v1 = load8<TIn>(ROW(Vp, k0, 32 + sr));              \
                         S.st_k0 = load8<TIn>(ROW(Kp, k0, sr)); S.st_k1 = load8<TIn>(ROW(Kp, k0, 32 + sr)); } while (0)
#define SWRITE_HK(bf) do { *(LDSA bf16x8*)(K_lds + (bf) * SHM_K + kws) = S.st_k0; *(LDSA bf16x8*)(K_lds + (bf) * SHM_K + kws + 32 * 256) = S.st_k1; } while (0)
#define SWRITE_HV(bf) do { *(LDSA bf16x8*)(V_lds + (bf) * SHM_V + vst0) = S.st_v0; *(LDSA bf16x8*)(V_lds + (bf) * SHM_V + vst1) = S.st_v1; } while (0)
#define SWRITE_H(bf) do { SWRITE_HV(bf); SWRITE_HK(bf); } while (0)
#define SLOAD_F(p, k0) do { S.sf0 = *(const f32x4*)ROW(p, k0, sr); S.sf1 = *(const f32x4*)(ROW(p, k0, sr) + 4);                \
                            S.sf2 = *(const f32x4*)ROW(p, k0, 32 + sr); S.sf3 = *(const f32x4*)(ROW(p, k0, 32 + sr) + 4); } while (0)
#define SWRITE_KF(bf) do { *(LDSA bf16x8*)(K_lds + (bf) * SHM_K + kws) = pack8(S.sf0, S.sf1); *(LDSA bf16x8*)(K_lds + (bf) * SHM_K + kws + 32 * 256) = pack8(S.sf2, S.sf3); } while (0)
#define SWRITE_VF(bf) do { *(LDSA bf16x8*)(V_lds + (bf) * SHM_V + vst0) = pack8(S.sf0, S.sf1); *(LDSA bf16x8*)(V_lds + (bf) * SHM_V + vst1) = pack8(S.sf2, S.sf3); } while (0)
template <class TIn, class TOut>
__device__ __forceinline__ void causal_swa_prime(const BlockRef<TIn, TOut>& cur, int W, lchar* lds, Seam<TIn>& S) {
    constexpr bool F32 = same_t<TIn, float>::v;
    const int tid = ltid(), wid = __builtin_amdgcn_readfirstlane(tid >> 6), lane = tid & 63, r32 = lane & 31, hi = lane >> 5;
    const int sr = tid >> 4, sc = (tid & 15) * 8, kws = KSWZ(sr, sc * 2); lchar* K_lds = lds + 2 * SHM_V;
    const int kb0 = (swa_jhi(cur.P0, SKV) - 1) * KVBLK;
    for (int d0 = 0; d0 < 8; ++d0) S.qr[d0] = load8<TIn>(cur.Q + (size_t)(wid * QBLK + r32) * D + d0 * 16 + hi * 8);
    if constexpr (F32) { SLOAD_F((const float*)cur.K, kb0); VMW(); SWRITE_KF(0); SBAR(); SLOAD_F((const float*)cur.V, kb0); }
    else { SLOAD_H(cur.K, cur.V, kb0); S.csv = *(const f32x4*)(cur.CS + 4 * tid); VMW(); SWRITE_HK(0); *(LDSA f32x4*)(lds + CS_OFF + 16 * tid) = S.csv; }
    __syncthreads();
}
template <class TIn, class TOut>
__device__ __forceinline__ void causal_swa_block(const BlockRef<TIn, TOut>& cur, const BlockRef<TIn, TOut>& nxt, int skv, int W, lchar* lds, Seam<TIn>& S) {
    constexpr bool F32 = same_t<TIn, float>::v;
    const int tid = ltid(), wid = __builtin_amdgcn_readfirstlane(tid >> 6), lane = tid & 63, r32 = lane & 31, hi = lane >> 5;
    const int j_lo = swa_jlo(cur.P0, W);
    int j_hi = (cur.P0 + QB - 1) / KVBLK + 1; if (j_hi > skv / KVBLK) j_hi = skv / KVBLK;
    const int NT = j_hi - j_lo;
    const int kbn = (swa_jhi(nxt.P0, skv) - 1) * KVBLK;
    const int qlo = cur.P0 + wid * QBLK, qm = qlo + r32 - 4 * hi;
    lchar* V_lds = lds; lchar* K_lds = lds + 2 * SHM_V;
    LDSA float* ws = (LDSA float*)(lds + 2 * SHM_V + 2 * SHM_K) + wid * 64; LDSA float* li_l = ws; LDSA float* al_l = ws + 32;
    float m_reg = -1e30f, l_reg = 0; f32x16 o[4] = {};
    const lchar* cs_lds = lds + CS_OFF; const float cqs = ((const LDSA float*)cs_lds)[cur.P0 + wid * QBLK + r32]; const lchar* csl = cs_lds + hi * 16;
    lchar* qsl = lds + QS_OFF + wid * 8192 + lane * 16;
#pragma unroll
    for (int d0 = QREG; d0 < 8; ++d0) *(LDSA bf16x8*)(qsl + d0 * 1024) = S.qr[d0];
    bf16x8 qh[QREG > 0 ? QREG : 1];
#pragma unroll
    for (int d0 = 0; d0 < QREG; ++d0) qh[d0] = S.qr[d0];
    const int sr = tid >> 4, sc = (tid & 15) * 8, vst0 = v_st(sr, sc), vst1 = v_st(32 + sr, sc), kws = KSWZ(sr, sc * 2);
    const int vb0 = (int)(uintptr_t)V_lds + v_rd_base(lane);
    const TIn* Kh = cur.K; const TIn* Vh = cur.V;
#define RESC(a) do { if (__any((a) < 1.f)) { if (hi == 0) al_l[r32] = (a); asm volatile("s_waitcnt lgkmcnt(0)" ::: "memory");              \
                     for (int d_ = 0; d_ < 4; ++d_) for (int r = 0; r < 16; ++r) o[d_][r] *= al_l[crow(r, hi)]; } } while (0)
#define KBASE(t) ((j_hi - 1 - (t)) * KVBLK)
#define ACT(t) (KBASE(t) <= qlo + QBLK - 1 && KBASE(t) + KVBLK - 1 >= qlo - W + 1)
#define MASKT(P0_, P1_, t) do { const int kb_ = KBASE(t); if ((!SK || ACT(t)) && (kb_ + KVBLK - 1 > qlo || kb_ <= qlo + QBLK - 1 - W)) mask_tile(P0_, P1_, qm - kb_, (unsigned)W); } while (0)
    constexpr int NQL = F32 ? 16 : 8;
    constexpr bool SK = WSKIP && !F32;
#define SEAM_K0() do { VMWN(NQL); if constexpr (F32) { SWRITE_KF(0); SBAR(); SLOAD_F((const float*)nxt.V, kbn); } else { SWRITE_HK(0); *(LDSA f32x4*)(lds + CS_OFF + 16 * tid) = S.csv; } SBAR(); } while (0)
    f32x16 pA0, pA1, pB0, pB1; float mnA, mnB, alA, alB; bf16x8 pa0, pa1, pa2, pa3;
    if constexpr (F32) { VMW(); SWRITE_VF(0); SBAR(); } else { SWRITE_HV(0); SBAR(); }
    if (NT > 1) { if constexpr (F32) SLOAD_F((const float*)Kh, KBASE(1)); else SLOAD_H(Kh, Vh, KBASE(1)); }
    SBAR(); qkt<0, SK>(pA0, pA1, K_lds, r32, hi, qsl, qh, ACT(0), csl + KBASE(0) * 4, cqs);
    if constexpr (F32) { if (NT > 1) { VMW(); SWRITE_KF(1); SBAR(); SLOAD_F((const float*)Vh, KBASE(1)); } }
    MASKT(pA0, pA1, 0); partialSM(pA0, pA1, m_reg, mnA, alA);
    if (NT > 1) { VMW(); if constexpr (F32) { SWRITE_VF(1); SBAR(); if (NT > 2) SLOAD_F((const float*)Kh, KBASE(2)); } else SWRITE_H(1); }
    __syncthreads();
#define HALF_STEP(PX0, PX1, mnX, alX, PY0, PY1, alY, t, KB, VB, SB) do {                                                      \
        SBAR(); qkt<KB, SK>(PX0, PX1, K_lds, r32, hi, qsl, qh, ACT(t), csl + KBASE(t) * 4, cqs);                                             \
        finishSM(PY0, PY1, alY, l_reg, pa0, pa1, pa2, pa3); SBAR();                                                           \
        if ((t) + 1 < NT) { if constexpr (F32) { VMW(); SWRITE_KF(SB); SBAR(); SLOAD_F((const float*)Vh, KBASE((t) + 1)); }  \
                            else { SLOAD_H(Kh, Vh, KBASE((t) + 1)); } SBAR(); }                                               \
        pv_tile<VB, SK>(o, vb0, pa0, pa1, pa2, pa3, ACT((t) - 1)); MASKT(PX0, PX1, (t)); partialSM(PX0, PX1, m_reg, mnX, alX);                                        \
        __syncthreads();                                                                                                      \
        if ((t) + 1 < NT) { VMW(); if constexpr (F32) { SWRITE_VF(SB); SBAR(); if ((t) + 2 < NT) SLOAD_F((const float*)Kh, KBASE((t) + 2)); } \
                            else { SWRITE_H(SB); } }                                                                          \
        RESC(alX); __syncthreads(); } while (0)
    for (int t = 1; t + 1 < NT; t += 2) {
        HALF_STEP(pB0, pB1, mnB, alB, pA0, pA1, alA, t, 1, 0, 0);
        HALF_STEP(pA0, pA1, mnA, alA, pB0, pB1, alB, t + 1, 0, 1, 1);
    }
    const bool even = (NT & 1) == 0;
    if (even) { SBAR(); qkt<1, SK>(pB0, pB1, K_lds, r32, hi, qsl, qh, ACT(NT - 1), csl + KBASE(NT - 1) * 4, cqs); SBAR(); }
#define QROW(e) (nxt.Q + (size_t)(wid * QBLK + r32) * D + ((e) >> 1) * 16 + hi * 8 + ((e) & 1) * 4)
    if constexpr (F32) { SLOAD_F((const float*)nxt.K, kbn); SBAR();
#pragma unroll
        for (int e = 0; e < 8; ++e) S.tq[e] = *(const f32x4*)QROW(e); }
    else { S.csv = *(const f32x4*)(nxt.CS + 4 * tid); SLOAD_H(nxt.K, nxt.V, kbn); SBAR();
#pragma unroll
        for (int d0 = 0; d0 < 8; ++d0) S.qr[d0] = load8<TIn>(nxt.Q + (size_t)(wid * QBLK + r32) * D + d0 * 16 + hi * 8); }
    SBAR();
    finishSM(pA0, pA1, alA, l_reg, pa0, pa1, pa2, pa3); SBAR();
    if constexpr (F32) {
#pragma unroll
        for (int e = 8; e < 16; ++e) S.tq[e] = *(const f32x4*)QROW(e); SBAR(); }
#undef QROW
    pv_tile<0, SK>(o, vb0, pa0, pa1, pa2, pa3, ACT(even ? NT - 2 : NT - 1));
    if (even) { MASKT(pB0, pB1, NT - 1); partialSM(pB0, pB1, m_reg, mnB, alB); __syncthreads(); RESC(alB);
        finishSM(pB0, pB1, alB, l_reg, pa0, pa1, pa2, pa3); SBAR(); pv_tile<1, SK>(o, vb0, pa0, pa1, pa2, pa3, ACT(NT - 1)); }
    SBAR(); SEAM_K0();
    if (hi == 0) li_l[r32] = l_reg; asm volatile("s_waitcnt lgkmcnt(0)" ::: "memory");
    float rli[16];
#pragma unroll
    for (int r = 0; r < 16; ++r) rli[r] = __builtin_amdgcn_rcpf(li_l[crow(r, hi)]);
    TOut* Ow = cur.O + (size_t)(wid * QBLK) * OLD; const TOut* OIw = cur.OI + (size_t)(wid * QBLK) * OLD;
#pragma unroll
    for (int r = 0; r < 16; ++r) { const int orow = crow(r, hi);
#pragma unroll
        for (int d0 = 0; d0 < 4; ++d0) { const float v = o[d0][r] * rli[r];
            if constexpr (same_t<TOut, float>::v) { Ow[(size_t)orow * OLD + d0 * 32 + r32] = v; }
            else { const float vn = __shfl_xor(v, 1);
                   if ((r32 & 1) == 0) { const size_t eo = (size_t)orow * OLD + d0 * 32 + r32; unsigned* pp = (unsigned*)(Ow + eo); const unsigned sp = *(const unsigned*)(OIw + eo);
                       *pp = cvtpk(v * __uint_as_float(sp << 16), vn * __uint_as_float(sp & 0xffff0000u)); } } } }
    if constexpr (F32) {
#pragma unroll
        for (int d0 = 0; d0 < 8; ++d0) S.qr[d0] = pack8(S.tq[2 * d0], S.tq[2 * d0 + 1]); }
    __syncthreads();
#undef RESC
#undef KBASE
#undef ACT
#undef MASKT
#undef SEAM_K0
#undef HALF_STEP
}
#undef ROW
#undef VMW
#undef VMWN
#undef SLOAD_H
#undef SWRITE_HK
#undef SWRITE_HV
#undef SWRITE_H
#undef SLOAD_F
#undef SWRITE_KF
#undef SWRITE_VF

}
namespace mk {
typedef unsigned short bf16_t;
typedef float f32x4 __attribute__((ext_vector_type(4)));
typedef float f32x2 __attribute__((ext_vector_type(2)));
typedef unsigned u32x4 __attribute__((ext_vector_type(4)));
typedef unsigned u32x2 __attribute__((ext_vector_type(2)));
typedef short bf16x8 __attribute__((ext_vector_type(8)));
typedef float f32x16 __attribute__((ext_vector_type(16)));
#define LAS __attribute__((address_space(3)))
typedef LAS float __attribute__((may_alias)) f32_ma;
typedef LAS unsigned short __attribute__((may_alias)) u16_ma;
typedef LAS unsigned __attribute__((may_alias)) u32_ma;
typedef LAS bf16x8 __attribute__((may_alias)) bf16x8_ma;
constexpr int MTOK = 8192, DM = 2048, SEQ = 2048;
constexpr int LDS_BYTES = 147456;
constexpr int NPHASE = 17;
constexpr size_t MiB = 1u << 20, KiB = 1u << 10;
constexpr size_t WS_W_S5IN = 0, WS_W_FOXIN = 32 * MiB, WS_W_POOLIN = 64 * MiB, WS_W_OUT = 80 * MiB, WS_W_GLU = 112 * MiB, WS_W_POOLG = 128 * MiB;
constexpr size_t WS_MISC = 130 * MiB, WS_HB = 136 * MiB, WS_U = 168 * MiB, WS_K = 200 * MiB, WS_V = 232 * MiB, WS_SZ = 264 * MiB, WS_HL = 296 * MiB, WS_END = (RESID_MODE == 2 ? 328 : 296) * MiB;
static_assert(WS_K - WS_U == 32 * MiB && WS_V - WS_K == 32 * MiB && WS_SZ - WS_V == 32 * MiB, "Epi::OSTR");
constexpr size_t MS_SSQ = 4096 * KiB  , MS_FLOG = 128 * KiB, MS_CS = 640 * KiB, MS_WF = 1152 * KiB, MS_ABAR = 1280 * KiB, MS_BBAR = 1408 * KiB, MS_CM = 2432 * KiB, MS_BAR = 3456 * KiB, BAR_BYTES = 49152;
struct Params { const float* in[21]; float* out; unsigned char* ws; int ph_lo, ph_hi; };

__device__ __forceinline__ unsigned f2bf(float f) { unsigned u = __float_as_uint(f); return (u + 0x7fffu + ((u >> 16) & 1u)) >> 16; }
__device__ __forceinline__ unsigned pk2(float lo, float hi) { return f2bf(lo) | (f2bf(hi) << 16); }
__device__ __forceinline__ float wave_sum(float v) {
#pragma unroll
    for (int o = 1; o < 64; o <<= 1) v += __shfl_xor(v, o);
    return v;
}
__device__ __forceinline__ int crow(int r, int hi) { return (r & 3) + 8 * (r >> 2) + 4 * hi; }

__device__ __forceinline__ void transpose_item(const float* W, int ldw, int K, int N, const float* kscale, bf16_t* WT, LAS float* scr, int item, int lane) {
    const int nblk = N / 64, kb = item / nblk, nb = item % nblk, k0 = 64 * kb, n0 = 64 * nb, r4 = lane >> 4, c4 = (lane & 15) * 4;
    f32x4 v[16];
#pragma unroll
    for (int i = 0; i < 16; ++i) v[i] = *(const f32x4*)(W + (size_t)(k0 + 4 * i + r4) * ldw + n0 + c4);
    if (kscale) {
#pragma unroll
        for (int i = 0; i < 16; ++i) v[i] = v[i] * kscale[k0 + 4 * i + r4]; }
#pragma unroll
    for (int i = 0; i < 16; ++i) { LAS float* d = scr + (4 * i + r4) * 65 + c4; d[0] = v[i][0]; d[1] = v[i][1]; d[2] = v[i][2]; d[3] = v[i][3]; }
    asm volatile("s_waitcnt lgkmcnt(0)" ::: "memory");
    const int c = lane & 7;
#pragma unroll
    for (int j = 0; j < 8; ++j) { const int n = (lane >> 3) + 8 * j; const LAS float* s = scr + (8 * c) * 65 + n;
        u32x4 o; o.x = pk2(s[0 * 65], s[1 * 65]); o.y = pk2(s[2 * 65], s[3 * 65]); o.z = pk2(s[4 * 65], s[5 * 65]); o.w = pk2(s[6 * 65], s[7 * 65]);
        *(u32x4*)(WT + (size_t)(n0 + n) * K + k0 + 8 * c) = o; }
    asm volatile("s_waitcnt lgkmcnt(0)" ::: "memory");
}
__device__ __forceinline__ double exp_small(double x) { double s = 1.0, t = 1.0;
#pragma unroll
    for (int n = 1; n <= 14; ++n) { t *= x * (1.0 / n); s += t; } return s; }
__device__ __forceinline__ double exp_d(double x) { double y = exp_small(x * (1.0 / 64.0));
#pragma unroll
    for (int i = 0; i < 6; ++i) y *= y; return y; }
__device__ __forceinline__ void sincos_d(double th, double& sn, double& cs) {
    const double k = __builtin_rint(th * 0.63661977236758134308);
    const double r = __builtin_fma(-k, 6.123233995736766e-17, __builtin_fma(-k, 1.5707963267948966, th)), r2 = r * r;
    double ts = r, ss = r, tc = 1.0, sc = 1.0;
#pragma unroll
    for (int n = 1; n <= 9; ++n) { tc *= -r2 * (1.0 / ((2 * n - 1) * (2 * n))); sc += tc; ts *= -r2 * (1.0 / ((2 * n) * (2 * n + 1))); ss += ts; }
    const int q = ((int)k) & 3;
    sn = (q == 0) ? ss : (q == 1) ? sc : (q == 2) ? -ss : -sc;
    cs = (q == 0) ? sc : (q == 1) ? -ss : (q == 2) ? -sc : ss;
}
#define PROIN(i) ((const float*)(const __attribute__((address_space(1))) float*)Pk->in[i])
__device__ __forceinline__ void transpose_dispatch(const __attribute__((address_space(4))) Params* Pk, LAS unsigned char* lds, int it, int wid, int lane) {
    unsigned char* ws = (unsigned char*)(__attribute__((address_space(1))) unsigned char*)Pk->ws;
    const float* normw = PROIN(1);
    LAS float* scr = (LAS float*)(lds + wid * 16640);
    int r = it;
    if (r < 4096) { const int j = r >> 11; transpose_item(PROIN(3) + (size_t)j * 2048 * 4096, 4096, 2048, 4096, normw + 3 * j * 2048, (bf16_t*)(ws + WS_W_S5IN) + (size_t)j * 4096 * 2048, scr, r & 2047, lane); return; } r -= 4096;
    if (r < 4096) { transpose_item(PROIN(14), 8208, 2048, 8192, normw + 2048, (bf16_t*)(ws + WS_W_FOXIN), scr, r, lane); return; } r -= 4096;
    if (r < 2048) { transpose_item(PROIN(18), 4096, 2048, 4096, normw + 2 * 2048, (bf16_t*)(ws + WS_W_POOLIN), scr, r, lane); return; } r -= 2048;
    if (r < 4096) { const int i = r >> 10; transpose_item(PROIN(2) + (size_t)i * 2048 * 2048, 2048, 2048, 2048, nullptr, (bf16_t*)(ws + WS_W_OUT) + (size_t)i * 2048 * 2048, scr, r & 1023, lane); return; } r -= 4096;
    if (r < 2048) { const int j = r >> 10; transpose_item(PROIN(12) + (size_t)j * 2048 * 2048, 2048, 2048, 2048, nullptr, (bf16_t*)(ws + WS_W_GLU) + (size_t)j * 2048 * 2048, scr, r & 1023, lane); return; } r -= 2048;
    { const int g = r >> 6; transpose_item(PROIN(19) + (size_t)g * 512 * 512, 512, 512, 512, nullptr, (bf16_t*)(ws + WS_W_POOLG) + (size_t)g * 512 * 512, scr, r & 63, lane); }
}
__device__ __forceinline__ void convert_rest(const __attribute__((address_space(4))) Params* Pk, LAS unsigned char* lds, int k0, int k1, int vb, int vg) {
    const int tid = ltid(), lane = tid & 63, wid = __builtin_amdgcn_readfirstlane(tid >> 6);
    for (int k = k0 + vb * 8 + wid; k < k1; k += vg * 8) {
        int r = k, it;
        if (r < 2048) it = 2048 + r; else { r -= 2048;
        if (r < 4096) it = 4096 + r; else { r -= 4096;
        if (r < 2048) it = 8192 + r; else { r -= 2048;
        if (r < 3072) it = 11264 + r; else { r -= 3072;
        if (r < 1024) it = 15360 + r; else it = 16384 + (r - 1024); } } } }
        transpose_dispatch(Pk, lds, it, wid, lane);
    }
}
__device__ __forceinline__ void prologue(const __attribute__((address_space(4))) Params* Pk, LAS unsigned char* lds) {
    const int tid = ltid(), lane = tid & 63, wid = __builtin_amdgcn_readfirstlane(tid >> 6);
    const int gw = lbid() * 8 + wid, NGW = lgrid() * 8, gt = lbid() * 512 + tid, NGT = lgrid() * 512;
    unsigned char* ws = (unsigned char*)(__attribute__((address_space(1))) unsigned char*)Pk->ws;
    const float* normw = PROIN(1);
    for (int k = gw; k < 4096; k += NGW)
        transpose_dispatch(Pk, lds, k < 2048 ? k : (k < 3072 ? 10240 + (k - 2048) : 14336 + (k - 3072)), wid, lane);
    { float* WF = (float*)(ws + WS_MISC + MS_WF); float* ssq = (float*)(ws + WS_MISC + MS_SSQ);
      bf16_t* WFb = (bf16_t*)WF;
      for (int i = gt; i < 65536; i += NGT) { const int k = i >> 5, h = i & 31; WFb[h * 2048 + k] = h < 16 ? (bf16_t)f2bf(PROIN(14)[(size_t)k * 8208 + 8192 + h] * normw[2048 + k]) : (bf16_t)0; }
      (void)ssq; }
    { bf16_t* HB = (bf16_t*)(ws + WS_HB); float* ssq = (float*)(ws + WS_MISC + MS_SSQ); const float* x = PROIN(0);
      for (int m = gw; m < MTOK; m += NGW) { const f32x4* xr = (const f32x4*)(x + (size_t)m * DM) + lane; float s = 0.f; u32x2* o = (u32x2*)(HB + (size_t)m * DM) + lane;
#pragma unroll
          for (int j = 0; j < 8; ++j) { const f32x4 v = xr[64 * j]; s += (v.x * v.x + v.y * v.y) + (v.z * v.z + v.w * v.w); o[64 * j] = (u32x2){pk2(v.x, v.y), pk2(v.z, v.w)}; }
          s = wave_sum(s); if (lane < 8) ssq[(size_t)m * 8 + lane] = lane == 0 ? s : 0.f; } }
    { float* abar = (float*)(ws + WS_MISC + MS_ABAR); bf16_t* bbarT = (bf16_t*)(ws + WS_MISC + MS_BBAR); bf16_t* cmT = (bf16_t*)(ws + WS_MISC + MS_CM);
      for (int it = gw; it < 256; it += NGW) { const int jg = it, p = lane;
          const double dt = exp_d((double)PROIN(6)[jg]);
          const double ar = (double)PROIN(4)[jg * 64 + p], ai = (double)PROIN(5)[jg * 64 + p];
          const double mag = exp_d(ar * dt); double sn, cs; sincos_d(ai * dt, sn, cs);
          const double abr = mag * cs, abi = mag * sn, den = ar * ar + ai * ai, xr = abr - 1.0;
          const double fr = (xr * ar + abi * ai) / den, fi = (abi * ar - xr * ai) / den;
          abar[(jg * 64 + p) * 2] = (float)abr; abar[(jg * 64 + p) * 2 + 1] = (float)abi;
          const float* br = PROIN(7) + (size_t)(jg * 64 + p) * 16; const float* bi = PROIN(8) + (size_t)(jg * 64 + p) * 16;
          unsigned wr_[8], wi_[8];
#pragma unroll
          for (int c = 0; c < 8; ++c) { const double r0 = br[2 * c], i0 = bi[2 * c], r1 = br[2 * c + 1], i1 = bi[2 * c + 1];
              wr_[c] = pk2((float)(fr * r0 - fi * i0), (float)(fr * r1 - fi * i1)); wi_[c] = pk2((float)(fr * i0 + fi * r0), (float)(fr * i1 + fi * r1)); }
          u32x4* dr = (u32x4*)(bbarT + ((size_t)jg * 128 + p) * 16); u32x4* di = (u32x4*)(bbarT + ((size_t)jg * 128 + 64 + p) * 16);
          dr[0] = (u32x4){wr_[0], wr_[1], wr_[2], wr_[3]}; dr[1] = (u32x4){wr_[4], wr_[5], wr_[6], wr_[7]};
          di[0] = (u32x4){wi_[0], wi_[1], wi_[2], wi_[3]}; di[1] = (u32x4){wi_[4], wi_[5], wi_[6], wi_[7]};
#pragma unroll
          for (int c = 0; c < 16; ++c) { const size_t ci = ((size_t)jg * 16 + c) * 64 + p;
              ((unsigned*)cmT)[((size_t)jg * 16 + c) * 64 + p] = pk2(PROIN(9)[ci], -PROIN(10)[ci]); }
      } }
}

__device__ __forceinline__ float gelu_tanh(float x) { const float p = __builtin_fmaf(x * x, -0.10294324f, -2.30220819f); return x * __builtin_amdgcn_rcpf(1.f + __builtin_amdgcn_exp2f(p * x)); }
typedef LAS f32x4 __attribute__((may_alias)) f32x4_ma;
template <bool OUT>
__device__ __forceinline__ void s5_chunks(LAS unsigned char* buf, const bf16_t* Ug, bf16_t* Gg, const bf16x8 (&bfrag)[4], const bf16x8 (&cfrag)[8], const f32x4 da, const f32x4 db,
                                          float ar, float ai, float& hr, float& hi_, int lane, int r32, int hi) {
    LAS unsigned char* Hb = buf + 8192;
    const int swz = (lane >> 2) & 3, wsw = (r32 >> 2) & 3;
    const LAS unsigned char* rre = buf + lane * 64; const LAS unsigned char* rim = buf + (64 + lane) * 64;
    bf16x8 a_nx = *(const bf16x8*)(Ug + (size_t)r32 * DM + hi * 8);
    for (int c = 0; c < 16; ++c) {
        const bf16x8 a = a_nx;
        if (c + 1 < 16) a_nx = *(const bf16x8*)(Ug + (size_t)((c + 1) * 32 + r32) * DM + hi * 8);
        const size_t ro = (size_t)(c * 32 + r32) * DM + 4 * hi;
        u32x2 ua = {0u, 0u}, ub = {0u, 0u};
        if (OUT) { ua = *(const u32x2*)(Ug + ro); ub = *(const u32x2*)(Ug + ro + 8); }
        f32x16 d[4];
#pragma unroll
        for (int jt = 0; jt < 4; ++jt) { d[jt] = f32x16{}; d[jt] = __builtin_amdgcn_mfma_f32_32x32x16_bf16(a, bfrag[jt], d[jt], 0, 0, 0); }
#pragma unroll
        for (int hh = 0; hh < 2; ++hh) {
#pragma unroll
            for (int jt = 0; jt < 4; ++jt)
#pragma unroll
                for (int rg = 0; rg < 2; ++rg) { const int r0 = 8 * hh + 4 * rg;
                    *(f32x4_ma*)(buf + (jt * 32 + r32) * 64 + (((2 * rg + hi) ^ wsw) * 16)) = (f32x4){d[jt][r0], d[jt][r0 + 1], d[jt][r0 + 2], d[jt][r0 + 3]}; }
            f32x4 R[4], I[4];
#pragma unroll
            for (int j = 0; j < 4; ++j) { R[j] = *(const f32x4_ma*)(rre + ((j ^ swz) * 16)); I[j] = *(const f32x4_ma*)(rim + ((j ^ swz) * 16)); }
#pragma unroll
            for (int q = 0; q < 4; ++q) {
                LAS unsigned char* rw = Hb + (16 * hh + 4 * q) * 272;
#pragma unroll
                for (int k = 0; k < 4; ++k) {
                    const float nr = __builtin_fmaf(ar, hr, __builtin_fmaf(-ai, hi_, R[q][k])), ni = __builtin_fmaf(ar, hi_, __builtin_fmaf(ai, hr, I[q][k])); hr = nr; hi_ = ni;
                    if (OUT) ((u32_ma*)(rw + 272 * k))[lane] = pg8::cvt_pk_bf16(hr, hi_);
                }
            }
        }
        if (OUT) {
            f32x16 y = {};
#pragma unroll
            for (int kk = 0; kk < 8; ++kk) { const bf16x8 hf = *(const bf16x8_ma*)(Hb + r32 * 272 + (kk * 16 + hi * 8) * 2); y = __builtin_amdgcn_mfma_f32_32x32x16_bf16(cfrag[kk], hf, y, 0, 0, 0); }
            const float a0 = gelu_tanh(y[0] + da[0] * pg8::bf_lo(ua.x)), a1 = gelu_tanh(y[1] + da[1] * pg8::bf_hi(ua.x)), a2 = gelu_tanh(y[2] + da[2] * pg8::bf_lo(ua.y)), a3 = gelu_tanh(y[3] + da[3] * pg8::bf_hi(ua.y));
            const float b0 = gelu_tanh(y[4] + db[0] * pg8::bf_lo(ub.x)), b1 = gelu_tanh(y[5] + db[1] * pg8::bf_hi(ub.x)), b2 = gelu_tanh(y[6] + db[2] * pg8::bf_lo(ub.y)), b3 = gelu_tanh(y[7] + db[3] * pg8::bf_hi(ub.y));
            *(u32x2*)(Gg + ro) = (u32x2){pg8::cvt_pk_bf16(a0, a1), pg8::cvt_pk_bf16(a2, a3)}; *(u32x2*)(Gg + ro + 8) = (u32x2){pg8::cvt_pk_bf16(b0, b1), pg8::cvt_pk_bf16(b2, b3)};
        }
    }
}
__device__ __forceinline__ void s5_pass1_direct(const bf16_t* Ug, const bf16x8 (&bfrag)[4], const float* abg  , float& hr, float& hi_, int lane, int r32, int hi) {
    float wr[2][16], wi[2][16], a32r[2], a32i[2];
#pragma unroll
    for (int s = 0; s < 2; ++s) {
        const float ar = abg[(32 * s + r32) * 2], ai = abg[(32 * s + r32) * 2 + 1];
        float pr[32], pi[32]; pr[0] = 1.f; pi[0] = 0.f;
#pragma unroll
        for (int k = 1; k < 32; ++k) { pr[k] = pr[k - 1] * ar - pi[k - 1] * ai; pi[k] = pr[k - 1] * ai + pi[k - 1] * ar; }
        a32r[s] = pr[31] * ar - pi[31] * ai; a32i[s] = pr[31] * ai + pi[31] * ar;
#pragma unroll
        for (int r = 0; r < 16; ++r) { const int k0 = 31 - (r & 3) - 8 * (r >> 2); wr[s][r] = hi ? pr[k0 - 4] : pr[k0]; wi[s][r] = hi ? pi[k0 - 4] : pi[k0]; }
    }
    float Er[2] = {0.f, 0.f}, Ei[2] = {0.f, 0.f};
    bf16x8 a_nx = *(const bf16x8*)(Ug + (size_t)r32 * DM + hi * 8);
    for (int c = 0; c < 16; ++c) {
        const bf16x8 a = a_nx;
        if (c + 1 < 16) a_nx = *(const bf16x8*)(Ug + (size_t)((c + 1) * 32 + r32) * DM + hi * 8);
        f32x16 d[4];
#pragma unroll
        for (int jt = 0; jt < 4; ++jt) { d[jt] = f32x16{}; d[jt] = __builtin_amdgcn_mfma_f32_32x32x16_bf16(a, bfrag[jt], d[jt], 0, 0, 0); }
#pragma unroll
        for (int s = 0; s < 2; ++s) {
            float er = 0.f, ei = 0.f;
#pragma unroll
            for (int r = 0; r < 16; ++r) { const float br = d[s][r], bi = d[2 + s][r];
                er = __builtin_fmaf(wr[s][r], br, __builtin_fmaf(-wi[s][r], bi, er)); ei = __builtin_fmaf(wr[s][r], bi, __builtin_fmaf(wi[s][r], br, ei)); }
            er += __shfl_xor(er, 32); ei += __shfl_xor(ei, 32);
            const float nr = __builtin_fmaf(a32r[s], Er[s], __builtin_fmaf(-a32i[s], Ei[s], er)), ni = __builtin_fmaf(a32r[s], Ei[s], __builtin_fmaf(a32i[s], Er[s], ei)); Er[s] = nr; Ei[s] = ni;
        }
    }
    hr = lane < 32 ? Er[0] : Er[1]; hi_ = lane < 32 ? Ei[0] : Ei[1];
}
__device__ __forceinline__ void s5_phase(LAS unsigned char* lds, const bf16_t* U, bf16_t* G, const float* abar, const bf16_t* bbarT, const bf16_t* cmT, const float* dskip, int p0, int p1, int pstride) {
    const int tid = ltid(), lane = tid & 63, wid = __builtin_amdgcn_readfirstlane(tid >> 6), r32 = lane & 31, hi = lane >> 5;
    LAS unsigned char* buf = lds + wid * 16896; f32_ma* ex = (f32_ma*)(lds + 8 * 16896);
    for (int pair = p0; pair < p1; pair += pstride) {
        const int bg = pair * 2 + (wid >> 2), seg = wid & 3, b = bg >> 7, g = bg & 127;
        const float ar = abar[(g * 64 + lane) * 2], ai = abar[(g * 64 + lane) * 2 + 1];
        bf16x8 bfrag[4], cfrag[8];
#pragma unroll
        for (int jt = 0; jt < 4; ++jt) bfrag[jt] = *(const bf16x8*)(bbarT + ((size_t)g * 128 + jt * 32 + r32) * 16 + hi * 8);
        const size_t rowbase = (size_t)b * SEQ + seg * 512;
        const bf16_t* Ug = U + rowbase * DM + g * 16; bf16_t* Gg = G + rowbase * DM + g * 16;
        float hr = 0.f, hi_ = 0.f;
        if (seg != 3) s5_pass1_direct(Ug, bfrag, abar + (size_t)g * 64 * 2, hr, hi_, lane, r32, hi);
        ex[(wid * 64 + lane) * 2] = hr; ex[(wid * 64 + lane) * 2 + 1] = hi_;
        __syncthreads();
        asm volatile("" ::: "memory");
#pragma unroll
        for (int kk = 0; kk < 8; ++kk) { cfrag[kk] = (bf16x8){0, 0, 0, 0, 0, 0, 0, 0}; if (r32 < 16) cfrag[kk] = *(const bf16x8*)(cmT + ((size_t)g * 16 + r32) * 128 + kk * 16 + hi * 8); }
        const f32x4 da = *(const f32x4*)(dskip + g * 16 + 4 * hi), db = *(const f32x4*)(dskip + g * 16 + 8 + 4 * hi);
        float pr = ar, pi = ai;
#pragma unroll
        for (int i = 0; i < 9; ++i) { const float nr = pr * pr - pi * pi, ni = 2.f * pr * pi; pr = nr; pi = ni; }
        hr = 0.f; hi_ = 0.f;
        for (int s = 0; s < seg; ++s) { const float er = ex[(((wid & 4) + s) * 64 + lane) * 2], ei = ex[(((wid & 4) + s) * 64 + lane) * 2 + 1];
            const float nr = pr * hr - pi * hi_ + er, ni = pr * hi_ + pi * hr + ei; hr = nr; hi_ = ni; }
        s5_chunks<true>(buf, Ug, Gg, bfrag, cfrag, da, db, ar, ai, hr, hi_, lane, r32, hi);
        __syncthreads();
    }
}

__device__ __forceinline__ void flog_phase(LAS unsigned char* lds, const bf16_t* h, const float* ssq, const bf16_t* WFb, const float* fbias, float* flog, int r0, int r1, int rstride) {
    const int tid = ltid(), lane = tid & 63, wid = __builtin_amdgcn_readfirstlane(tid >> 6), r32 = lane & 31, hi = lane >> 5;
    LAS float* part = (LAS float*)lds;
    for (int rb = r0; rb < r1; rb += rstride) {
        const bf16_t* ap = h + (size_t)(rb * 32 + r32) * DM + wid * 256 + hi * 8;
        const bf16_t* bp = WFb + (size_t)r32 * DM + wid * 256 + hi * 8;
        bf16x8 a[16], b[16];
#pragma unroll
        for (int i = 0; i < 16; ++i) { a[i] = *(const bf16x8*)(ap + i * 16); b[i] = *(const bf16x8*)(bp + i * 16); }
        f32x16 d = {};
#pragma unroll
        for (int i = 0; i < 16; ++i) d = __builtin_amdgcn_mfma_f32_32x32x16_bf16(a[i], b[i], d, 0, 0, 0);
#pragma unroll
        for (int r = 0; r < 16; ++r) part[(wid * 32 + crow(r, hi)) * 33 + r32] = d[r];
        __syncthreads();
        { const int row = tid >> 4, hh = tid & 15; float v = 0.f;
#pragma unroll
          for (int w = 0; w < 8; ++w) v += part[(w * 32 + row) * 33 + hh];
          const int grow = rb * 32 + row;
          const f32x4 q0 = *(const f32x4*)(ssq + (size_t)grow * 8), q1 = *(const f32x4*)(ssq + (size_t)grow * 8 + 4);
          const float f = v * rsqrtf((((q0[0] + q0[1]) + (q0[2] + q0[3])) + ((q1[0] + q1[1]) + (q1[2] + q1[3]))) * (1.0f / 2048.0f) + 1e-6f) + fbias[hh];
          flog[(size_t)grow * 16 + hh] = fminf(f, 0.f) - __logf(1.f + __expf(-fabsf(f))); }
        __syncthreads();
    }
}
__device__ __forceinline__ void cs_qknorm_phase(LAS unsigned char* lds, const float* flog, float* cs, bf16_t* Q, bf16_t* K, const float* qw, const float* kw, int half, int vb, int vg) {
    const int tid = ltid(), lane = tid & 63, wid = __builtin_amdgcn_readfirstlane(tid >> 6);
    f32_ma* red = (f32_ma*)lds;
    for (int seq = 32 * half + vb; seq < 32 * half + 32; seq += vg) {
        const int b = seq >> 4, hh = seq & 15; float v[4];
#pragma unroll
        for (int i = 0; i < 4; ++i) v[i] = flog[((size_t)b * SEQ + 4 * tid + i) * 16 + hh];
        v[1] += v[0]; v[2] += v[1]; v[3] += v[2];
        float inc = v[3];
#pragma unroll
        for (int o = 1; o < 64; o <<= 1) { const float n = __shfl_up(inc, o); if (lane >= o) inc += n; }
        if (lane == 63) red[wid] = inc;
        __syncthreads();
        float base = 0.f;
        for (int w = 0; w < wid; ++w) base += red[w];
        const float ex = base + inc - v[3], inv = 11.313708498984761f;
        *(f32x4*)(cs + (size_t)seq * SEQ + 4 * tid) = (f32x4){(ex + v[0]) * inv, (ex + v[1]) * inv, (ex + v[2]) * inv, (ex + v[3]) * inv};
        __syncthreads();
    }
    const int gw = vb * 8 + wid, NGW = vg * 8, sub = lane >> 4, l16 = lane & 15;
    const f32x4 wq0 = *(const f32x4*)(qw + l16 * 8), wq1 = *(const f32x4*)(qw + l16 * 8 + 4), wk0 = *(const f32x4*)(kw + l16 * 8), wk1 = *(const f32x4*)(kw + l16 * 8 + 4);
    for (int it0 = gw; it0 < 32768; it0 += 4 * NGW) {
        u32x4 raw[4]; bf16_t* pp[4]; bool kk[4];
#pragma unroll
        for (int q = 0; q < 4; ++q) { const int it = it0 + q * NGW; kk[q] = it >= 16384; pp[q] = (kk[q] ? K : Q) + ((size_t)((16384 * half + (it & 16383)) * 4 + sub)) * 128 + l16 * 8; raw[q] = (it < 32768) ? *(const u32x4*)pp[q] : (u32x4){0u, 0u, 0u, 0u}; }
#pragma unroll
        for (int q = 0; q < 4; ++q) { const int it = it0 + q * NGW;
            f32x4 a, bq; pg8::unpack8f(raw[q], a, bq);
            float ss = (a[0] * a[0] + a[1] * a[1]) + (a[2] * a[2] + a[3] * a[3]) + (bq[0] * bq[0] + bq[1] * bq[1]) + (bq[2] * bq[2] + bq[3] * bq[3]);
            ss += __shfl_xor(ss, 1); ss += __shfl_xor(ss, 2); ss += __shfl_xor(ss, 4); ss += __shfl_xor(ss, 8);
            const float rs = rsqrtf(ss * (1.0f / 128.0f) + 1e-6f);
            a = a * rs * (kk[q] ? wk0 : wq0); bq = bq * rs * (kk[q] ? wk1 : wq1);
            if (it < 32768) *(u32x4*)pp[q] = pg8::pack8f(a, bq); }
    }
}
template <int W>
__device__ __forceinline__ void pool_item(const bf16_t* U, bf16_t* G, int row0, int t0, int col0) {
    u32x4 rows[15 + W];
#pragma unroll
    for (int j = 0; j < 15 + W; ++j) { const int t = t0 - (W - 1) + j; rows[j] = (u32x4){0u, 0u, 0u, 0u}; if (t >= 0) rows[j] = *(const u32x4*)(U + (size_t)(row0 - (W - 1) + j) * DM + col0); }
    f32x4 s0 = {0.f, 0.f, 0.f, 0.f}, s1 = s0;
#pragma unroll
    for (int j = 0; j < W - 1; ++j) { f32x4 a, b; pg8::unpack8f(rows[j], a, b); s0 += a; s1 += b; }
#pragma unroll
    for (int i = 0; i < 16; ++i) { const int t = t0 + i;
        f32x4 a, b; pg8::unpack8f(rows[W - 1 + i], a, b); s0 += a; s1 += b;
        const float ic = 1.0f / (float)((t + 1) < W ? (t + 1) : W);
        *(u32x4*)(G + (size_t)(row0 + i) * DM + col0) = pg8::pack8f(s0 * ic - a, s1 * ic - b);
        f32x4 c, d; pg8::unpack8f(rows[i], c, d); s0 -= c; s1 -= d; }
}
__device__ __forceinline__ void pool_phase(const bf16_t* U, bf16_t* G, int i0, int i1, int istride) {
    for (int item = i0 + ltid(); item < i1; item += istride) {
        const int rb = item >> 8, ch = item & 255, col0 = ch * 8, grp = col0 >> 9, row0 = rb * 16, t0 = row0 & (SEQ - 1);
        if (grp == 0) pool_item<2>(U, G, row0, t0, col0); else if (grp == 1) pool_item<4>(U, G, row0, t0, col0); else if (grp == 2) pool_item<8>(U, G, row0, t0, col0); else pool_item<16>(U, G, row0, t0, col0);
    }
}
__device__ __forceinline__ att::BlockRef<att::bf16, att::bf16> att_ref(int bh, int qb, const bf16_t* Q, const bf16_t* K, const bf16_t* V, bf16_t* YZ, const bf16_t* SZI, const float* cs) {
    att::BlockRef<att::bf16, att::bf16> r; const int b = bh >> 4, hh = bh & 15;
    r.Q = (const att::bf16*)Q + ((size_t)bh * SEQ + (size_t)qb * 256) * 128; r.K = (const att::bf16*)K + (size_t)bh * SEQ * 128; r.V = (const att::bf16*)V + (size_t)bh * SEQ * 128;
    r.O = (att::bf16*)YZ + ((size_t)b * SEQ + (size_t)qb * 256) * DM + hh * 128; r.OI = (const att::bf16*)SZI + ((size_t)b * SEQ + (size_t)qb * 256) * DM + hh * 128; r.CS = cs + (size_t)bh * SEQ; r.P0 = qb * 256;
    return r;
}
__device__ __forceinline__ void attn_phase(att::lchar* lds, const bf16_t* Q, const bf16_t* K, const bf16_t* V, bf16_t* YZ, const bf16_t* SZI, float* cs, const float* flog, int L0, int total, int stride) {
    int L = L0; if (L >= total) return;
    { const int tid = ltid(), lane = tid & 63, wid = __builtin_amdgcn_readfirstlane(tid >> 6), seq = L >> 2, b = seq >> 4, hh = seq & 15;
      LAS float* red = (LAS float*)lds; float v[4];
#pragma unroll
      for (int i = 0; i < 4; ++i) v[i] = flog[((size_t)b * SEQ + 4 * tid + i) * 16 + hh];
      v[1] += v[0]; v[2] += v[1]; v[3] += v[2];
      float inc = v[3];
#pragma unroll
      for (int o = 1; o < 64; o <<= 1) { const float n = __shfl_up(inc, o); if (lane >= o) inc += n; }
      if (lane == 63) red[wid] = inc;
      __syncthreads();
      float base = 0.f;
      for (int w = 0; w < wid; ++w) base += red[w];
      const float ex = base + inc - v[3], inv = 11.313708498984761f;
      *(f32x4*)(cs + (size_t)seq * SEQ + 4 * tid) = (f32x4){(ex + v[0]) * inv, (ex + v[1]) * inv, (ex + v[2]) * inv, (ex + v[3]) * inv};
      asm volatile("s_waitcnt vmcnt(0)" ::: "memory");
      __syncthreads(); }
    int pass = 0;
    att::BlockRef<att::bf16, att::bf16> cur = att_ref(L >> 2, L & 3, Q, K, V, YZ, SZI, cs);
    att::Seam<att::bf16> S;
    att::causal_swa_prime<att::bf16, att::bf16>(cur, SEQ, lds, S);
    for (;;) {
        const bool more_pass = pass == 0, more_item = L + stride < total, last = !more_pass && !more_item;
        int passn = pass + 1, Ln = L;
        if (!more_pass) { passn = 0; Ln = more_item ? L + stride : L; }
        const int qbn = passn ? 7 - (Ln & 3) : (Ln & 3);
        const att::BlockRef<att::bf16, att::bf16> nxt = last ? cur : att_ref(Ln >> 2, qbn, Q, K, V, YZ, SZI, cs);
        att::causal_swa_block<att::bf16, att::bf16>(cur, nxt, SEQ, SEQ, lds, S);
        if (last) break;
        cur = nxt; pass = passn; L = Ln;
    }
}

#define XB_TMO      128
#define XB_XCNT(j)  (256  + 64 * (j))
#define XB_XSUB(j)  (1280 + 64 * (j))
#define XB_XGEN(j)  (2304 + 64 * (j))
#define XB_TOP      3328
#define XB_TOPGEN   3392
#define XCD_BAR_WORDS 3456
#define XB_SPIN_CAP (1u << 18)

__device__ __forceinline__ unsigned xb_ld(unsigned* p)              { return __hip_atomic_load(p, __ATOMIC_RELAXED, __HIP_MEMORY_SCOPE_AGENT); }
__device__ __forceinline__ unsigned xb_add(unsigned* p, unsigned v) { return __hip_atomic_fetch_add(p, v, __ATOMIC_RELAXED, __HIP_MEMORY_SCOPE_AGENT); }
__device__ __forceinline__ unsigned xb_xcc_id() { return (unsigned)__builtin_amdgcn_s_getreg((3 << 11) | 20) & 0xFu; }
#define XB_SPIN(cond, bar) do { unsigned _sp = 0; while (cond) { __builtin_amdgcn_s_sleep(1); \
    if ((++_sp & 255u) == 0u) { if (xb_ld(&(bar)[XB_TMO])) break; if (_sp > XB_SPIN_CAP) { atomicAdd(&(bar)[XB_TMO], 1u); break; } } } } while (0)

struct XcdBarrier {
    unsigned* bar; unsigned x; unsigned G;
    volatile LAS unsigned* st;
};

__device__ __forceinline__ XcdBarrier xcd_barrier_post(unsigned* bar, volatile LAS unsigned* st) {
    XcdBarrier b; b.bar = bar; b.x = xb_xcc_id(); b.st = st; b.G = 0;
    if (threadIdx.x == 0) (void)xb_add(&bar[XB_XCNT(b.x)], 1u);
    return b;
}
__device__ __forceinline__ void xcd_barrier_complete(unsigned* bar, unsigned x, unsigned& nloc, unsigned& nx, const unsigned G) {
    unsigned sum, cnt, mine, sp = 0u;
    for (;;) {
        sum = 0u; cnt = 0u; mine = 0u;
#pragma unroll
        for (unsigned j = 0; j < 16; ++j) { const unsigned c = xb_ld(&bar[XB_XCNT(j)]); sum += c; cnt += (c > 0u) ? 1u : 0u; mine = (j == x) ? c : mine; }
        if (sum == G) break;
        __builtin_amdgcn_s_sleep(1);
        if ((++sp & 255u) == 0u) { if (xb_ld(&bar[XB_TMO])) break; if (sp > XB_SPIN_CAP) { atomicAdd(&bar[XB_TMO], 1u); break; } }
    }
    nloc = mine > 0u ? mine : 1u; nx = cnt > 0u ? cnt : 1u;
}

__device__ __forceinline__ void xcd_barrier(const XcdBarrier& b) {
    asm volatile("s_waitcnt vmcnt(0)" ::: "memory");
    __syncthreads();
    if (threadIdx.x == 0) {
        unsigned* bar = b.bar;
        __builtin_amdgcn_s_waitcnt(0);
        unsigned nloc = b.st[0], nx = b.st[1];
        if (nloc == 0u) { xcd_barrier_complete(bar, b.x, nloc, nx, b.G); b.st[0] = nloc; b.st[1] = nx; }
        const unsigned old = xb_add(&bar[XB_XSUB(b.x)], 1u);
        const unsigned gen = old / nloc;
        if (old + 1u == (gen + 1u) * nloc) {
            __builtin_amdgcn_fence(__ATOMIC_RELEASE, "agent");
            asm volatile("s_waitcnt vmcnt(0)" ::: "memory");
            const unsigned og = xb_add(&bar[XB_TOP], 1u);
            const unsigned tg = og / nx;
            if (og + 1u == (tg + 1u) * nx) xb_add(&bar[XB_TOPGEN], 1u);
            else XB_SPIN(xb_ld(&bar[XB_TOPGEN]) == tg, bar);
            __builtin_amdgcn_fence(__ATOMIC_ACQUIRE, "agent");
            xb_add(&bar[XB_XGEN(b.x)], 1u);
            asm volatile("s_waitcnt vmcnt(0)" ::: "memory");
        } else {
            XB_SPIN(xb_ld(&bar[XB_XGEN(b.x)]) == gen, bar);
            __builtin_amdgcn_fence(__ATOMIC_ACQUIRE, "agent");
            asm volatile("s_waitcnt vmcnt(0)" ::: "memory");
        }
    }
    __syncthreads();
}

template <class T> __device__ __forceinline__ T* asglobal(T* p) { return (T*)(__attribute__((address_space(1))) T*)p; }
typedef const __attribute__((address_space(4))) Params* KArgs;
#define PIN(i) asglobal(Pk->in[i])
#define WSP(T, off) ((T*)(ws + (off)))
__global__ void __launch_bounds__(512, 2) mega(Params P) {
    extern __shared__ __attribute__((aligned(16))) unsigned char lds[];
    cg::grid_group grid = cg::this_grid();
    volatile LAS unsigned* bst = (volatile LAS unsigned*)((LAS unsigned char*)lds + LDS_BYTES - 64);
    if (threadIdx.x < 4) bst[threadIdx.x] = 0u;
    __syncthreads();
    const int half = lbid() >> 7, vb = lbid() & 127, vg = 128;
    { unsigned* bw = (unsigned*)(P.ws + WS_MISC + MS_BAR); for (int i = blockIdx.x * 512 + threadIdx.x; i < (int)(BAR_BYTES / 4); i += gridDim.x * 512) bw[i] = 0u; }
    grid.sync();
    (void)xcd_barrier_post((unsigned*)(P.ws + WS_MISC + MS_BAR), bst);
    (void)xcd_barrier_post((unsigned*)(P.ws + WS_MISC + MS_BAR) + (1 + (blockIdx.x >> 7)) * XCD_BAR_WORDS, bst + 2);
#define XBAR_G() do { XcdBarrier xb_; xb_.bar = (unsigned*)(asglobal(((KArgs)__builtin_amdgcn_kernarg_segment_ptr())->ws) + WS_MISC + MS_BAR); xb_.x = xb_xcc_id(); xb_.st = bst; xb_.G = 256u; xcd_barrier(xb_); } while (0)
#define XBAR_H() do { XcdBarrier xb_; xb_.bar = (unsigned*)(asglobal(((KArgs)__builtin_amdgcn_kernarg_segment_ptr())->ws) + WS_MISC + MS_BAR) + (1 + half) * XCD_BAR_WORDS; xb_.x = xb_xcc_id(); xb_.st = bst + 2; xb_.G = 128u; xcd_barrier(xb_); } while (0)
    { KArgs Pk = (KArgs)__builtin_amdgcn_kernarg_segment_ptr(); asm volatile("" : "+s"(Pk)); prologue(Pk, (LAS unsigned char*)lds); }
    XBAR_G();
    if (half) { KArgs Pk = (KArgs)__builtin_amdgcn_kernarg_segment_ptr(); asm volatile("" : "+s"(Pk)); convert_rest(Pk, (LAS unsigned char*)lds, 6272, 12544, vb, vg); __syncthreads(); }
    for (int ph = 1; ph < NPHASE; ++ph) {
        KArgs Pk = (KArgs)__builtin_amdgcn_kernarg_segment_ptr(); asm volatile("" : "+s"(Pk));
        unsigned char* ws = asglobal(Pk->ws);
        const int layer = (ph - 1) >> 2, sub = (ph - 1) & 3;
        const int kind = layer % 3, j = layer / 3;
        if (sub == 1) {
            if (kind == 0) s5_phase((LAS unsigned char*)lds, WSP(bf16_t, WS_U), WSP(bf16_t, WS_K), WSP(float, WS_MISC + MS_ABAR) + (size_t)j * 128 * 64 * 2, WSP(bf16_t, WS_MISC + MS_BBAR) + (size_t)j * 128 * 128 * 16,
                                    WSP(bf16_t, WS_MISC + MS_CM) + (size_t)j * 128 * 16 * 128, PIN(11) + j * DM, 128 * half + vb, 128 * half + 128, vg);
            else if (kind == 1) {   }
            else pool_phase(WSP(bf16_t, WS_U), WSP(bf16_t, WS_K), 65536 * half + vb * 512, 65536 * half + 65536, vg * 512);
        } else if (sub == 2 && kind == 1) {
            attn_phase((att::lchar*)lds, WSP(bf16_t, WS_U), WSP(bf16_t, WS_K), WSP(bf16_t, WS_V), WSP(bf16_t, WS_SZ), WSP(bf16_t, WS_SZ), WSP(float, WS_MISC + MS_CS), WSP(float, WS_MISC + MS_FLOG), 128 * half + vb, 128 * half + 128, vg);
        } else {
            const bf16_t* gA; const bf16_t* gB; int gN = DM, gK = DM, ggrp = 0, emode;
            const float* e_ssq = nullptr; const bf16_t* e_g = nullptr; const float* e_vec = nullptr; const float* e_hin = nullptr; bf16_t* e_hb = nullptr; float* e_ssqo = nullptr; float* e_hout = nullptr;
            float* ssq = WSP(float, WS_MISC + MS_SSQ);
            if (sub == 0) {
                gA = WSP(bf16_t, WS_HB); e_ssq = ssq + (size_t)layer * MTOK * 8;
                if (kind == 0) { gB = WSP(bf16_t, WS_W_S5IN) + (size_t)j * 4096 * 2048; gN = 4096; emode = pg8::EM_UZ; }
                else if (kind == 1) { gB = WSP(bf16_t, WS_W_FOXIN); gN = 8192; emode = pg8::EM_QKVZ; }
                else { gB = WSP(bf16_t, WS_W_POOLIN); gN = 4096; emode = pg8::EM_UZ; }
            } else if (sub == 2) {
                gA = WSP(bf16_t, WS_K); e_g = gA;
                if (kind == 0) { gB = WSP(bf16_t, WS_W_GLU) + (size_t)j * 2048 * 2048; emode = pg8::EM_GLU; e_vec = PIN(13) + j * DM; }
                else { gB = WSP(bf16_t, WS_W_POOLG); gK = 512; ggrp = 2; emode = pg8::EM_POOL; e_vec = PIN(20); }
            } else {
                gA = WSP(bf16_t, WS_SZ); gB = WSP(bf16_t, WS_W_OUT) + (size_t)layer * 2048 * 2048; emode = pg8::EM_OUT;
                e_hin = layer == 0 ? PIN(0) : (const float*)asglobal(Pk->out); e_hout = asglobal(Pk->out);
                e_hb = layer < 3 ? WSP(bf16_t, WS_HB) : nullptr; e_ssqo = layer < 3 ? ssq + (size_t)(layer + 1) * MTOK * 8 : nullptr;
            }
            { const pg8::Gemm g{gA, gB, MTOK / 2, gN, gK, DM, ggrp};
              const pg8::Epi E{(PG8_LAS float*)((PG8_LAS unsigned char*)lds + 131072), PIN(15), PIN(16), emode, (emode == pg8::EM_OUT || (DRAIN_ALL && emode >= pg8::EM_GLU)) ? 1 : 0, e_ssq, WSP(bf16_t, WS_U), WSP(bf16_t, WS_SZ), WSP(bf16_t, WS_SZ), e_g, e_vec, e_hin, nullptr, nullptr, e_hout, e_hb, nullptr, e_ssqo};
              pg8::StaticOrder S; S.init(MTOK / 2, gN, vg, vb, 16 * half);
              pg8::gemm_phase<pg8::Epi, pg8::StaticOrder, true, true>((PG8_LAS unsigned char*)lds, g, S, E); }
            if (sub == 0 && kind == 1) { __syncthreads();
                flog_phase((LAS unsigned char*)lds, WSP(bf16_t, WS_HB), ssq + (size_t)layer * MTOK * 8, WSP(bf16_t, WS_MISC + MS_WF), PIN(17), WSP(float, WS_MISC + MS_FLOG), 128 * half + vb, 128 * half + 128, vg); }
        }
        if (ph == 4) { if (!half) { convert_rest(Pk, (LAS unsigned char*)lds, 0, 6272, vb, vg); } XBAR_G(); }
        else if (ph + 1 < NPHASE && !(sub == 1 && kind == 1)) XBAR_H();
    }
}
}

extern "C" void kernel_launch(void* const* d_in, const int* in_sizes, int n_in, void* d_out, int out_size, void* d_ws, size_t ws_size, hipStream_t stream) {
    static int grid = 0;
    if (grid == 0) {
        if (n_in != 21 || out_size != mk::MTOK * mk::DM || ws_size < mk::WS_END) { fprintf(stderr, "kernel_launch: unexpected problem (n_in %d, out %d, ws %zu < %zu)\n", n_in, out_size, ws_size, (size_t)mk::WS_END); grid = -1; return; }
        int dev = 0, cus = 0, per_cu = 0;
        if (hipGetDevice(&dev) != hipSuccess || hipDeviceGetAttribute(&cus, hipDeviceAttributeMultiprocessorCount, dev) != hipSuccess) { grid = -1; return; }
        if (hipFuncSetAttribute((const void*)mk::mega, hipFuncAttributeMaxDynamicSharedMemorySize, mk::LDS_BYTES) != hipSuccess) { fprintf(stderr, "kernel_launch: hipFuncSetAttribute failed\n"); grid = -1; return; }
        if (hipOccupancyMaxActiveBlocksPerMultiprocessor(&per_cu, (const void*)mk::mega, 512, mk::LDS_BYTES) != hipSuccess || per_cu < 1) { fprintf(stderr, "kernel_launch: occupancy query says %d blocks per CU\n", per_cu); grid = -1; return; }
        grid = cus * per_cu;
        if (grid != 256) { fprintf(stderr, "kernel_launch: this build splits the grid into two halves of 128 workgroups and needs exactly 256 (got %d)\n", grid); grid = -1; return; }
    }
    if (grid < 0) return;
    mk::Params p{};
    for (int i = 0; i < 21; ++i) p.in[i] = (const float*)d_in[i];
    p.out = (float*)d_out; p.ws = (unsigned char*)d_ws;
    p.ph_lo = 0; p.ph_hi = mk::NPHASE; void* args[] = {&p};
    hipError_t e = hipLaunchCooperativeKernel((const void*)mk::mega, dim3(grid), dim3(512), args, mk::LDS_BYTES, stream);
    if (e != hipSuccess) fprintf(stderr, "kernel_launch: cooperative launch failed: %s (grid %d)\n", hipGetErrorString(e), grid);
}
```

```cpp
#include <hip/hip_runtime.h>
#include <hip/hip_cooperative_groups.h>
#include <hip/hip_bf16.h>
#include <cstdio>
#include <cstdint>
namespace cg = cooperative_groups;
#ifndef PROBE_PH
#define PROBE_PH (-1)
#endif
#ifndef PROBE_NOEPI
#define PROBE_NOEPI 0
#endif
#ifndef PROBE_SYNC
#define PROBE_SYNC 0
#endif
#ifndef PROBE_NOFLOG
#define PROBE_NOFLOG 0
#endif
#ifndef RESID_MODE
#define RESID_MODE 0
#endif
#ifndef HALF_DELAY_TICKS
#define HALF_DELAY_TICKS 0
#endif
#ifndef DRAIN_ALL
#define DRAIN_ALL 1
#endif
#ifndef MK_MULTI
#define MK_MULTI 0
#endif
__device__ __forceinline__ int ltid() { int t = threadIdx.x; asm volatile("" : "+v"(t)); return t; }
__device__ __forceinline__ int lgrid() { int g = gridDim.x; asm volatile("" : "+s"(g)); return g; }
__device__ __forceinline__ int lbid() { int b = blockIdx.x; asm volatile("" : "+s"(b)); return b; }
namespace pg8 {
#define PG8_LAS __attribute__((address_space(3)))
typedef unsigned short bf16_t;
typedef short bf16x8 __attribute__((ext_vector_type(8)));
typedef float f32x4 __attribute__((ext_vector_type(4)));
typedef unsigned u32x4 __attribute__((ext_vector_type(4)));
constexpr int BM = 256, BK = 64, HALF = 128, HTB = HALF * BK * 2  , STAGE_BYTES = 8 * HTB, NXCD = 8, WGM = 8;

__host__ __device__ __forceinline__ int lds_byte(int r, int c) { const int st = (r >> 4) * 2 + (c >> 5), rr = r & 15, cc = c & 31, ob = rr * 64 + cc * 2; return st * 1024 + (ob ^ (((ob >> 9) & 1) << 5)); }
__host__ __device__ __forceinline__ void stage_rc(int b, int& R, int& C) { const int st = b / 1024, sb = b % 1024, swz = sb ^ (((sb >> 9) & 1) << 5); R = (st >> 1) * 16 + swz / 64; C = (st & 1) * 32 + (swz % 64) / 2; }
__host__ __device__ __forceinline__ int perm32(int rho) { const int n = rho >> 4, i = rho & 15; return 8 * (i >> 2) + 4 * n + (i & 3); }

struct Unit { int pm, pn; };
struct Gemm { const bf16_t* A; const bf16_t* Bt; int M, N, K, lda, grp; };

struct StaticOrder {
    int nM, nN, nwg, G, c, pmo, nx;
    __host__ __device__ void init(int M, int N, int G_, int c_, int pmo_ = 0, int nx_ = NXCD) { nM = M / BM; nN = N / BM; nwg = nM * nN; G = G_; c = c_; pmo = pmo_; nx = nx_; }
    __host__ __device__ bool next(int i, Unit& u) const {
        const long L = (long)i * G + c; if (L >= nwg) return false;
        int wgid = (int)L; { const int q = nwg / nx, r = nwg % nx, xcd = wgid % nx, off = wgid / nx; wgid = (xcd < r ? xcd * (q + 1) : r * (q + 1) + (xcd - r) * q) + off; }
        const int nig = WGM * nN, gid = wgid / nig, fm = gid * WGM, gsz = (nM - fm) < WGM ? (nM - fm) : WGM;
        u.pm = fm + ((wgid % nig) % gsz) + pmo; u.pn = (wgid % nig) / gsz; return true;
    }
    __device__ __forceinline__ void a_ready(const Unit&) const {}
    __device__ __forceinline__ void done(const Unit&) const {}
};

__device__ __forceinline__ unsigned cvt_pk_bf16(float lo, float hi) { unsigned r; asm volatile("v_cvt_pk_bf16_f32 %0, %1, %2" : "=v"(r) : "v"(lo), "v"(hi)); return r; }
typedef float f32x2 __attribute__((ext_vector_type(2)));
typedef unsigned u32x2 __attribute__((ext_vector_type(2)));
#ifndef EPI_RB
#define EPI_RB 8
#endif
#ifndef EPI_PREFETCH
#define EPI_PREFETCH 0
#endif
#ifndef EPI_NT
#define EPI_NT 0
#endif
#if EPI_NT
#define NTST(p, v) __builtin_nontemporal_store((v), (p))
#else
#define NTST(p, v) (*(p) = (v))
#endif
#ifndef EPI_WT
#define EPI_WT 1
#endif
#if 1
#endif
__device__ __forceinline__ float bf_lo(unsigned w) { return __uint_as_float(w << 16); }
__device__ __forceinline__ float bf_hi(unsigned w) { return __uint_as_float(w & 0xffff0000u); }
__device__ __forceinline__ float sigm_f(float v) { return __builtin_amdgcn_rcpf(1.f + __expf(-v)); }
__device__ __forceinline__ float silu_f(float v) { return v * sigm_f(v); }
__device__ __forceinline__ u32x4 pack8f(f32x4 a, f32x4 b) { u32x4 w; w.x = cvt_pk_bf16(a[0], a[1]); w.y = cvt_pk_bf16(a[2], a[3]); w.z = cvt_pk_bf16(b[0], b[1]); w.w = cvt_pk_bf16(b[2], b[3]); return w; }
__device__ __forceinline__ void unpack8f(u32x4 w, f32x4& a, f32x4& b) { a = (f32x4){bf_lo(w.x), bf_hi(w.x), bf_lo(w.y), bf_hi(w.y)}; b = (f32x4){bf_lo(w.z), bf_hi(w.z), bf_lo(w.w), bf_hi(w.w)}; }

enum { EM_UZ = 0, EM_QKVZ = 1, EM_GLU = 2, EM_POOL = 3, EM_OUT = 4 };
struct Epi {
    static constexpr bool PERM = true, AFTER_DRAIN = false;
    PG8_LAS float* xl; const float* qw; const float* kw;
    int mode; int drain;
    const float* ssq;
    bf16_t *o0, *o3;
    static constexpr size_t OSTR = (size_t)16 << 20;
    bf16_t* o3w;
    const bf16_t* gsrc;
    const float* vec;
    const float* hin; const bf16_t* hbin; const bf16_t* hlin; float* hout; bf16_t* hb; bf16_t* hl; float* ssq_out;
    __device__ __forceinline__ void operator()(const f32x4 (&acc)[2][2][4][2], const Unit& u, int wr, int wc, int fr, int fq) const {
        const int row0 = u.pm * BM + wr * 64 + fr;
        const int cw = wc * 32 + 8 * fq;
        if (mode == EM_UZ || mode == EM_QKVZ) {
            const int region = u.pn >> 3, ct = (u.pn & 7) * BM;
            const bool zreg = (mode == EM_UZ) ? (region == 1) : (region == 3);
            bf16_t* base = o0 + (size_t)(zreg ? 3 : region) * OSTR;
            const __amdgpu_buffer_rsrc_t wrs = __builtin_amdgcn_make_buffer_rsrc((void*)o0, (short)0, (int)(4 * OSTR * 2), 0x00020000);
            const unsigned wbase = (unsigned)((zreg ? 3 : region) * (OSTR * 2));
            const bool headmajor = (mode == EM_QKVZ) && !zreg;
            if (mode == EM_QKVZ && region < 2) {
                float rsv[2][4];
#pragma unroll
                for (int ai = 0; ai < 2; ++ai)
#pragma unroll
                    for (int m = 0; m < 4; ++m) {
                        const int row = row0 + ai * HALF + m * 16, rl = ai * HALF + wr * 64 + m * 16 + fr;
                        const f32x4 q0 = *(const f32x4*)(ssq + (size_t)row * 8), q1 = *(const f32x4*)(ssq + (size_t)row * 8 + 4);
                        const float rs = rsqrtf((((q0[0] + q0[1]) + (q0[2] + q0[3])) + ((q1[0] + q1[1]) + (q1[2] + q1[3]))) * (1.0f / 2048.0f) + 1e-6f);
                        rsv[ai][m] = rs;
#pragma unroll
                        for (int bj = 0; bj < 2; ++bj) { const f32x4 v0 = acc[ai][bj][m][0] * rs, v1 = acc[ai][bj][m][1] * rs;
                            float s = (v0[0] * v0[0] + v0[1] * v0[1]) + (v0[2] * v0[2] + v0[3] * v0[3]) + (v1[0] * v1[0] + v1[1] * v1[1]) + (v1[2] * v1[2] + v1[3] * v1[3]);
                            s += __shfl_xor(s, 16); s += __shfl_xor(s, 32);
                            if (fq == 0) xl[(rl * 2 + bj) * 4 + wc] = s; }
                    }
                asm volatile("s_waitcnt lgkmcnt(0)\n\ts_barrier" ::: "memory");
                const float* nw = qw + cw; const float* nk = kw + cw;
                f32x4 w0 = *(const f32x4*)nw, w1 = *(const f32x4*)(nw + 4); const f32x4 k0 = *(const f32x4*)nk, k1 = *(const f32x4*)(nk + 4);
                if (region == 1) { w0 = k0; w1 = k1; }
#pragma unroll
                for (int ai = 0; ai < 2; ++ai)
#pragma unroll
                    for (int m = 0; m < 4; ++m) {
                        const int row = row0 + ai * HALF + m * 16, rl = ai * HALF + wr * 64 + m * 16 + fr, b = row >> 11, tt = row & 2047;
#pragma unroll
                        for (int bj = 0; bj < 2; ++bj) { const f32x4 pp = *(const PG8_LAS f32x4*)(xl + (rl * 2 + bj) * 4);
                            const float rh = rsqrtf(((pp[0] + pp[1]) + (pp[2] + pp[3])) * (1.0f / 128.0f) + 1e-6f) * rsv[ai][m];
                            const f32x4 v0 = acc[ai][bj][m][0] * rh * w0, v1 = acc[ai][bj][m][1] * rh * w1;
                            const int head = (ct >> 7) + bj; const size_t off = ((size_t)((b * 16 + head) * 2048 + tt)) * 128 + cw;
                            *(u32x4*)(base + off) = pack8f(v0, v1); }
                    }
            } else
#pragma unroll
            for (int ai = 0; ai < 2; ++ai)
#pragma unroll
                for (int m = 0; m < 4; ++m) {
                    const int row = row0 + ai * HALF + m * 16;
                    const f32x4 q0 = *(const f32x4*)(ssq + (size_t)row * 8), q1 = *(const f32x4*)(ssq + (size_t)row * 8 + 4);
                    const float rs = rsqrtf((((q0[0] + q0[1]) + (q0[2] + q0[3])) + ((q1[0] + q1[1]) + (q1[2] + q1[3]))) * (1.0f / 2048.0f) + 1e-6f);
#pragma unroll
                    for (int bj = 0; bj < 2; ++bj) {
                        f32x4 v0 = acc[ai][bj][m][0] * rs, v1 = acc[ai][bj][m][1] * rs;
                        if (zreg) {
#pragma unroll
                            for (int e = 0; e < 4; ++e) { v0[e] = silu_f(v0[e]); v1[e] = silu_f(v1[e]); }
                        }
                        size_t off;
                        if (headmajor) { const int head = (ct >> 7) + bj, b = row >> 11, t = row & 2047; off = ((size_t)((b * 16 + head) * 2048 + t)) * 128 + cw; }
                        else off = (size_t)row * 2048 + ct + bj * HALF + cw;
                        if (EPI_WT == 2) __builtin_amdgcn_raw_buffer_store_b128(pack8f(v0, v1), wrs, wbase + (unsigned)(off * 2), 0, 16);
                        else NTST((u32x4*)(base + off), pack8f(v0, v1));
                    }
                }
        } else if (mode == EM_GLU || mode == EM_POOL) {
            const int col0 = u.pn * BM + cw;
            f32x4 bv[2][2];
#pragma unroll
            for (int bj = 0; bj < 2; ++bj) { bv[bj][0] = *(const f32x4*)(vec + col0 + bj * HALF); bv[bj][1] = *(const f32x4*)(vec + col0 + bj * HALF + 4); }
#pragma unroll
            for (int ai = 0; ai < 2; ++ai) {
                u32x4 sr[4][2], gr[4][2];
#pragma unroll
                for (int m = 0; m < 4; ++m)
#pragma unroll
                    for (int bj = 0; bj < 2; ++bj) { const size_t off = (size_t)(row0 + ai * HALF + m * 16) * 2048 + col0 + bj * HALF;
                        sr[m][bj] = *(const u32x4*)(o3 + off); if (mode == EM_GLU) gr[m][bj] = *(const u32x4*)(gsrc + off); else gr[m][bj] = (u32x4){0u, 0u, 0u, 0u}; }
#pragma unroll
                for (int m = 0; m < 4; ++m)
#pragma unroll
                    for (int bj = 0; bj < 2; ++bj) { const size_t off = (size_t)(row0 + ai * HALF + m * 16) * 2048 + col0 + bj * HALF;
                        f32x4 s0, s1; unpack8f(sr[m][bj], s0, s1);
                        f32x4 v0 = acc[ai][bj][m][0], v1 = acc[ai][bj][m][1];
                        if (mode == EM_GLU) { f32x4 g0, g1; unpack8f(gr[m][bj], g0, g1);
#pragma unroll
                            for (int e = 0; e < 4; ++e) { v0[e] = g0[e] * sigm_f(v0[e] + bv[bj][0][e]); v1[e] = g1[e] * sigm_f(v1[e] + bv[bj][1][e]); }
                        } else { v0 = v0 * bv[bj][0]; v1 = v1 * bv[bj][1]; }
                        *(u32x4*)(o3w + off) = pack8f(v0 * s0, v1 * s1); }
                asm volatile("" ::: "memory");
            }
        }
    }
    __device__ __forceinline__ void prefetch(const Unit& u, PG8_LAS unsigned char* lds, int wid, int lane) const {
        if (!EPI_PREFETCH || mode < EM_GLU) return;
        PG8_LAS unsigned* dump = (PG8_LAS unsigned*)(lds + 135168 + wid * 256);
        if (mode == EM_OUT) {
#pragma unroll
            for (int k = 0; k < 4; ++k) { const int li = wid * 256 + k * 64 + lane, r = li >> 3, l = li & 7;
                __builtin_amdgcn_global_load_lds((const unsigned*)(hin + (size_t)(u.pm * BM + r) * 2048 + u.pn * BM + l * 32), dump, 4, 0, 0); }
        } else {
#pragma unroll
            for (int k = 0; k < 2; ++k) { const int li = wid * 128 + k * 64 + lane, r = li >> 2, l = li & 3; const size_t off = (size_t)(u.pm * BM + r) * 2048 + u.pn * BM + l * 64;
                __builtin_amdgcn_global_load_lds((const unsigned*)(o3 + off), dump, 4, 0, 0);
                if (mode == EM_GLU) __builtin_amdgcn_global_load_lds((const unsigned*)(gsrc + off), dump, 4, 0, 0); }
        }
    }
    template <int ai>
    __device__ __forceinline__ void fused_half(const f32x4 (&acc)[2][2][4][2], const Unit& u, int wr, int wc, int fr, int fq, PG8_LAS float* T, int wid, int lane, const f32x4 bv) const {
        constexpr int LDW = 260, RB = EPI_RB;
        const int colw = wc * 32 + 8 * fq, rl0 = wr * 64 + fr, gcol = u.pn * BM + lane * 4;
        const size_t goff = (size_t)(u.pm * BM + ai * HALF + wid) * 2048 + gcol;
#pragma unroll
        for (int m = 0; m < 4; ++m)
#pragma unroll
            for (int bj = 0; bj < 2; ++bj) { PG8_LAS float* d = T + (rl0 + m * 16) * LDW + bj * HALF + colw; *(PG8_LAS f32x4*)d = acc[ai][bj][m][0]; *(PG8_LAS f32x4*)(d + 4) = acc[ai][bj][m][1]; }
        __syncthreads();
        for (int blk = 0; blk < 16 / RB; ++blk) {
            const size_t bo = goff + (size_t)blk * (8 * RB) * 2048;
            const PG8_LAS float* Tb = T + (wid + 8 * RB * blk) * LDW + lane * 4;
            if (mode == EM_OUT) {
                f32x4 hv[RB];
#pragma unroll
                for (int i = 0; i < RB; ++i) { if (hin) hv[i] = *(const f32x4*)(hin + bo + (size_t)i * 8 * 2048); else { const u32x2 r = *(const u32x2*)(hbin + bo + (size_t)i * 8 * 2048); hv[i] = (f32x4){bf_lo(r.x), bf_hi(r.x), bf_lo(r.y), bf_hi(r.y)};
                        if (hlin) { const u32x2 q = *(const u32x2*)(hlin + bo + (size_t)i * 8 * 2048); hv[i] = hv[i] + (f32x4){bf_lo(q.x), bf_hi(q.x), bf_lo(q.y), bf_hi(q.y)}; } } }
#pragma unroll
                for (int i = 0; i < RB; ++i) {
                    const f32x4 v = *(const PG8_LAS f32x4*)(Tb + 8 * i * LDW) + hv[i];
                    const size_t o = bo + (size_t)i * 8 * 2048;
                    if (hout) { if (EPI_WT) __builtin_amdgcn_raw_buffer_store_b128(__builtin_bit_cast(u32x4, v), __builtin_amdgcn_make_buffer_rsrc((void*)hout, (short)0, (int)(8192 * 2048 * 4), 0x00020000), (unsigned)(o * 4), 0, 16); else *(f32x4*)(hout + o) = v; }
                    if (hb) { u32x2 w; w.x = cvt_pk_bf16(v[0], v[1]); w.y = cvt_pk_bf16(v[2], v[3]); *(u32x2*)(hb + o) = w;
                        if (hl) { const f32x4 r = v - (f32x4){bf_lo(w.x), bf_hi(w.x), bf_lo(w.y), bf_hi(w.y)}; u32x2 wl; wl.x = cvt_pk_bf16(r[0], r[1]); wl.y = cvt_pk_bf16(r[2], r[3]); *(u32x2*)(hl + o) = wl; } }
                    if (ssq_out) { float s = (v[0] * v[0] + v[1] * v[1]) + (v[2] * v[2] + v[3] * v[3]);
#pragma unroll
                        for (int q = 1; q < 64; q <<= 1) s += __shfl_xor(s, q);
                        if (lane == 0) ssq_out[(size_t)(u.pm * BM + ai * HALF + wid + 8 * RB * blk + 8 * i) * 8 + u.pn] = s; }
                }
            } else {
                u32x2 sv[RB], gv[RB];
#pragma unroll
                for (int i = 0; i < RB; ++i) { sv[i] = *(const u32x2*)(o3 + bo + (size_t)i * 8 * 2048); gv[i] = (mode == EM_GLU) ? *(const u32x2*)(gsrc + bo + (size_t)i * 8 * 2048) : (u32x2){0u, 0u}; }
#pragma unroll
                for (int i = 0; i < RB; ++i) {
                    f32x4 v = *(const PG8_LAS f32x4*)(Tb + 8 * i * LDW);
                    const f32x4 s4 = {bf_lo(sv[i].x), bf_hi(sv[i].x), bf_lo(sv[i].y), bf_hi(sv[i].y)};
                    if (mode == EM_GLU) { const f32x4 g4 = {bf_lo(gv[i].x), bf_hi(gv[i].x), bf_lo(gv[i].y), bf_hi(gv[i].y)};
#pragma unroll
                        for (int q = 0; q < 4; ++q) v[q] = g4[q] * sigm_f(v[q] + bv[q]);
                    } else v = v * bv;
                    v = v * s4;
                    u32x2 w; w.x = cvt_pk_bf16(v[0], v[1]); w.y = cvt_pk_bf16(v[2], v[3]); *(u32x2*)(o3w + bo + (size_t)i * 8 * 2048) = w;
                }
            }
        }
        __syncthreads();
    }
    __device__ __forceinline__ void fused(const f32x4 (&acc)[2][2][4][2], const Unit& u, int wr, int wc, int fr, int fq, PG8_LAS unsigned char* lds, int wid, int lane) const {
        f32x4 bv = {0.f, 0.f, 0.f, 0.f};
        if (mode != EM_OUT) bv = *(const f32x4*)(vec + u.pn * BM + lane * 4);
        fused_half<0>(acc, u, wr, wc, fr, fq, (PG8_LAS float*)lds, wid, lane, bv);
        fused_half<1>(acc, u, wr, wc, fr, fq, (PG8_LAS float*)lds, wid, lane, bv);
    }
};
template <class Epi, class Sched, bool ALIGN_EPI = false, bool SP2 = false>
__device__ __forceinline__ void gemm_phase(PG8_LAS unsigned char* lds, const Gemm g, const Sched S, const Epi E) {
    const int tid = ltid(), wid = __builtin_amdgcn_readfirstlane(tid >> 6), lane = tid & 63, wr = wid >> 2, wc = wid & 3, fr = lane & 15, fq = lane >> 4;
    const int K = g.K, nt = K / BK;
    unsigned voffA[2], voffB[2];
#pragma unroll
    for (int i = 0; i < 2; ++i) { int R, C; stage_rc(tid * 16 + i * 8192, R, C); const int Rb = Epi::PERM ? ((R & ~31) + perm32(R & 31)) : R;
        voffA[i] = (unsigned)(R * g.lda + C) * 2u; voffB[i] = (unsigned)(Rb * K + C) * 2u; }
    const size_t kstep = (size_t)(BK * 2);
    const size_t hstepA = (size_t)HALF * g.lda * 2, hstepB = (size_t)HALF * K * 2;
    const size_t tstepA = 2 * hstepA, tstepB = 2 * hstepB;
#define PG8_GOFF(pn_) (g.grp ? (size_t)((pn_) / g.grp) * (size_t)K * 2 : (size_t)0)
    const unsigned ldsw = (unsigned)wid * 1024u;
    const int aoff = lds_byte(wr * 64 + fr, fq * 8), boff = lds_byte(wc * 32 + fr, fq * 8);
#define PG8_SA(b, h) (((b) * 2 + (h)) * HTB)
#define PG8_SB(b, h) ((4 + (b) * 2 + (h)) * HTB)
#define PG8_STAGE(bufoff, gbase, voff) do { _Pragma("unroll") for (int _i = 0; _i < 2; ++_i) \
        __builtin_amdgcn_global_load_lds((const unsigned*)((const char*)(gbase) + (voff)[_i]), (PG8_LAS unsigned*)(lds + (bufoff) + ldsw + _i * 8192), 16, 0, 0); } while (0)
#define PG8_LDA(dst, b, h) do { _Pragma("unroll") for (int m = 0; m < 4; ++m) _Pragma("unroll") for (int k = 0; k < 2; ++k) dst[m][k] = *(const PG8_LAS bf16x8*)(lds + PG8_SA(b, h) + aoff + m * 2048 + k * 1024); } while (0)
#define PG8_LDB(dst, b, h) do { _Pragma("unroll") for (int n = 0; n < 2; ++n) _Pragma("unroll") for (int k = 0; k < 2; ++k) dst[n][k] = *(const PG8_LAS bf16x8*)(lds + PG8_SB(b, h) + boff + n * 2048 + k * 1024); } while (0)
#define PG8_MMA(ai, bj, At, Bt) do { __builtin_amdgcn_s_setprio(1); _Pragma("unroll") for (int m = 0; m < 4; ++m) _Pragma("unroll") for (int n = 0; n < 2; ++n) _Pragma("unroll") for (int k = 0; k < 2; ++k) \
        acc[ai][bj][m][n] = __builtin_amdgcn_mfma_f32_16x16x32_bf16(Bt[n][k], At[m][k], acc[ai][bj][m][n], 0, 0, 0); __builtin_amdgcn_s_setprio(0); } while (0)
#define PG8_WAIT_V(n) asm volatile("s_waitcnt vmcnt(" #n ")" ::: "memory")
#define PG8_WAIT_L(n) asm volatile("s_waitcnt lgkmcnt(" #n ")" ::: "memory")
#define PG8_BAR __builtin_amdgcn_s_barrier()
#define PG8_SCHED __builtin_amdgcn_sched_barrier(0)
    Unit cur, nxt; int ui = 0;
    if (!S.next(0, cur)) return;
    f32x4 acc[2][2][4][2];
#pragma unroll
    for (int a = 0; a < 2; ++a)
#pragma unroll
        for (int b = 0; b < 2; ++b)
#pragma unroll
            for (int m = 0; m < 4; ++m)
#pragma unroll
                for (int n = 0; n < 2; ++n) acc[a][b][m][n] = (f32x4){0.f, 0.f, 0.f, 0.f};
    bf16x8 At[4][2], B0[2][2], B1[2][2];
    const char* cA = (const char*)g.A + (size_t)cur.pm * tstepA + PG8_GOFF(cur.pn); const char* cB = (const char*)g.Bt + (size_t)cur.pn * tstepB;
    S.a_ready(cur);
    E.prefetch(cur, lds, wid, lane);
    if constexpr (SP2) {
        PG8_STAGE(PG8_SB(0, 0), cB, voffB); PG8_STAGE(PG8_SB(0, 1), cB + hstepB, voffB); PG8_STAGE(PG8_SA(0, 0), cA, voffA); PG8_STAGE(PG8_SA(0, 1), cA + hstepA, voffA);
        if (wr == 1) PG8_BAR;
        PG8_WAIT_V(2); PG8_BAR;
        PG8_STAGE(PG8_SB(1, 0), cB + kstep, voffB); PG8_STAGE(PG8_SA(1, 0), cA + kstep, voffA); PG8_STAGE(PG8_SB(1, 1), cB + hstepB + kstep, voffB);
        PG8_WAIT_V(6); PG8_BAR;
    } else {
        PG8_STAGE(PG8_SB(0, 0), cB, voffB); PG8_STAGE(PG8_SA(0, 0), cA, voffA); PG8_STAGE(PG8_SB(0, 1), cB + hstepB, voffB); PG8_STAGE(PG8_SA(0, 1), cA + hstepA, voffA);
        if (wr == 1) PG8_BAR;
        PG8_WAIT_V(4); PG8_BAR;
        PG8_STAGE(PG8_SB(1, 0), cB + kstep, voffB); PG8_STAGE(PG8_SA(1, 0), cA + kstep, voffA); PG8_STAGE(PG8_SB(1, 1), cB + hstepB + kstep, voffB);
        PG8_WAIT_V(6); PG8_BAR;
    }
    for (;;) {
        const bool has_next = S.next(ui + 1, nxt);
        const char* nA = has_next ? (const char*)g.A + (size_t)nxt.pm * tstepA + PG8_GOFF(nxt.pn) : cA; const char* nB = has_next ? (const char*)g.Bt + (size_t)nxt.pn * tstepB : cB;
        for (int t = 0; t < nt; t += 2) {
            const bool last = (t == nt - 2);
            const char* a1 = cA + (size_t)(t + 1) * kstep;
            const char* a2 = last ? nA : cA + (size_t)(t + 2) * kstep; const char* b2 = last ? nB : cB + (size_t)(t + 2) * kstep;
            const char* a3 = a2 + kstep; const char* b3 = b2 + kstep;
            if (last && has_next) S.a_ready(nxt);
            if constexpr (SP2) {
            PG8_LDB(B0, 0, 0); PG8_LDB(B1, 0, 1); PG8_SCHED; PG8_LDA(At, 0, 0); PG8_STAGE(PG8_SA(1, 1), a1 + hstepA, voffA);
            PG8_WAIT_V(8); PG8_WAIT_L(0); PG8_BAR; PG8_MMA(0, 0, At, B0); PG8_MMA(0, 1, At, B1); PG8_BAR; PG8_SCHED;
            PG8_LDA(At, 0, 1); PG8_STAGE(PG8_SB(0, 0), b2, voffB); PG8_STAGE(PG8_SB(0, 1), b2 + hstepB, voffB); PG8_STAGE(PG8_SA(0, 0), a2, voffA);
            PG8_WAIT_V(8); PG8_WAIT_L(0); PG8_BAR; PG8_MMA(1, 0, At, B0); PG8_MMA(1, 1, At, B1); PG8_BAR; PG8_SCHED;
            PG8_LDB(B0, 1, 0); PG8_LDB(B1, 1, 1); PG8_SCHED; PG8_LDA(At, 1, 0); PG8_STAGE(PG8_SA(0, 1), a2 + hstepA, voffA);
            PG8_WAIT_V(8); PG8_WAIT_L(0); PG8_BAR; PG8_MMA(0, 0, At, B0); PG8_MMA(0, 1, At, B1); PG8_BAR; PG8_SCHED;
            PG8_LDA(At, 1, 1); PG8_STAGE(PG8_SB(1, 0), b3, voffB); PG8_STAGE(PG8_SB(1, 1), b3 + hstepB, voffB); PG8_STAGE(PG8_SA(1, 0), a3, voffA);
            PG8_WAIT_V(8); PG8_WAIT_L(0); PG8_BAR; PG8_MMA(1, 0, At, B0); PG8_MMA(1, 1, At, B1); PG8_BAR; PG8_SCHED;
            } else {
            PG8_LDB(B0, 0, 0); PG8_SCHED; PG8_LDA(At, 0, 0); PG8_STAGE(PG8_SA(1, 1), a1 + hstepA, voffA);
            PG8_WAIT_L(8); PG8_BAR; PG8_WAIT_L(0); PG8_MMA(0, 0, At, B0); PG8_BAR; PG8_SCHED;
            PG8_LDB(B1, 0, 1); PG8_STAGE(PG8_SB(0, 0), b2, voffB);
            PG8_BAR; PG8_WAIT_L(0); PG8_MMA(0, 1, At, B1); PG8_BAR;
            PG8_LDA(At, 0, 1); PG8_STAGE(PG8_SA(0, 0), a2, voffA);
            PG8_BAR; PG8_WAIT_L(0); PG8_MMA(1, 0, At, B0); PG8_BAR; PG8_SCHED;
            PG8_STAGE(PG8_SB(0, 1), b2 + hstepB, voffB);
            PG8_WAIT_V(6); PG8_BAR; PG8_MMA(1, 1, At, B1); PG8_BAR;
            PG8_LDB(B0, 1, 0); PG8_SCHED; PG8_LDA(At, 1, 0); PG8_STAGE(PG8_SA(0, 1), a2 + hstepA, voffA);
            PG8_WAIT_L(8); PG8_BAR; PG8_WAIT_L(0); PG8_MMA(0, 0, At, B0); PG8_BAR; PG8_SCHED;
            PG8_LDB(B1, 1, 1); PG8_STAGE(PG8_SB(1, 0), b3, voffB);
            PG8_BAR; PG8_WAIT_L(0); PG8_MMA(0, 1, At, B1); PG8_BAR;
            PG8_LDA(At, 1, 1); PG8_STAGE(PG8_SA(1, 0), a3, voffA);
            PG8_BAR; PG8_WAIT_L(0); PG8_MMA(1, 0, At, B0); PG8_BAR; PG8_SCHED;
            PG8_STAGE(PG8_SB(1, 1), b3 + hstepB, voffB);
            PG8_WAIT_V(6); PG8_BAR; PG8_MMA(1, 1, At, B1); PG8_BAR;
            }
        }
        if constexpr (ALIGN_EPI) { if (wr == 0) PG8_BAR; }
        if (!E.drain) { const int l2 = ltid() & 63; E(acc, cur, wr, wc, l2 & 15, l2 >> 4); S.done(cur); }
        if (!has_next) break;
#pragma unroll
        for (int a = 0; a < 2; ++a)
#pragma unroll
            for (int b = 0; b < 2; ++b)
#pragma unroll
                for (int m = 0; m < 4; ++m)
#pragma unroll
                    for (int n = 0; n < 2; ++n) acc[a][b][m][n] = (f32x4){0.f, 0.f, 0.f, 0.f};
        cur = nxt; cA = nA; cB = nB; ++ui;
        if constexpr (ALIGN_EPI) { if (wr == 1) PG8_BAR; }
    }
    PG8_WAIT_V(0);
    if constexpr (!ALIGN_EPI) { if (wr == 0) PG8_BAR; }
    PG8_BAR;
    if (E.drain) { const int l2 = ltid() & 63; E.fused(acc, cur, wr, wc, l2 & 15, l2 >> 4, lds, wid, l2); S.done(cur); }
#undef PG8_GOFF
#undef PG8_SA
#undef PG8_SB
#undef PG8_STAGE
#undef PG8_LDA
#undef PG8_LDB
#undef PG8_MMA
#undef PG8_WAIT_V
#undef PG8_WAIT_L
#undef PG8_BAR
#undef PG8_SCHED
}
}
namespace att {
enum { ORDER_NATURAL = 0, ORDER_REVERSED = 1, ORDER_PAIRED = 2, ORDER_XCD = 4 };
constexpr int B = 4, H = 16, HKV = 16, SQ = 2048, SKV = 2048, D = 128;
constexpr int QOFF = 0;
constexpr int WINDOW = SKV;
constexpr float THR = 8.f;
constexpr bool WSKIP = false;
constexpr float SCALE = 0.08838834764831845f;
constexpr int NW = 8, QBLK = 32, KVBLK = 64, QB = NW * QBLK;
constexpr int SHM_V = KVBLK * D * 2, SHM_K = KVBLK * D * 2;
constexpr int CS_OFF = 2 * SHM_V + 2 * SHM_K + NW * 64 * 4;
constexpr int QS_OFF = CS_OFF + SKV * 4;
constexpr int LDS_BYTES = QS_OFF + NW * 8192;
constexpr int OLD = 2048;
#ifndef ATT_QREG
#define ATT_QREG 8
#endif
constexpr int QREG = ATT_QREG;
static_assert(D == 128 && SQ % QB == 0 && SKV % KVBLK == 0 && H % HKV == 0 && QOFF >= 0 && QOFF + SQ <= SKV && WINDOW >= 1, "geometry");

using bf16 = __hip_bfloat16;
typedef short bf16x8 __attribute__((ext_vector_type(8)));
typedef short s16x4 __attribute__((ext_vector_type(4)));
typedef float f32x16 __attribute__((ext_vector_type(16)));
typedef float f32x4 __attribute__((ext_vector_type(4)));
typedef unsigned u32x4 __attribute__((ext_vector_type(4)));
template <class A, class Bt> struct same_t { static constexpr bool v = false; };
template <class A> struct same_t<A, A> { static constexpr bool v = true; };

#define LDSA __attribute__((address_space(3)))
typedef LDSA char lchar;
#define KSWZ(row, colB) ((row) * 256 + ((colB) ^ (((row) & 7) << 4)))
#define SBAR() __builtin_amdgcn_sched_barrier(0)
__device__ __forceinline__ int v_st(int k, int c) { const int kk = (k & ~0xC) | ((k & 4) << 1) | ((k & 8) >> 1); return ((kk >> 3) * 4 + (c >> 5)) * 512 + ((kk & 7) * 32 + (c & 31)) * 2; }
__device__ __forceinline__ int v_rd_base(int lane) { return ((lane & 3) << 3) | (((lane >> 2) & 3) << 6) | (((lane >> 4) & 1) << 5) | (((lane >> 5) & 1) << 8); }
constexpr int v_rd_off(int d0, int ks, int half) { return d0 * 512 + ks * 4096 + half * 2048; }
__device__ __forceinline__ int crow(int r, int hi) { return (r & 3) + 8 * (r >> 2) + 4 * hi; }
__device__ __forceinline__ unsigned cvtpk(float lo, float hi) {
    unsigned r; asm volatile("v_cvt_pk_bf16_f32 %0, %1, %2" : "=v"(r) : "v"(lo), "v"(hi)); return r;
}
__device__ __forceinline__ bf16x8 pack8(f32x4 a, f32x4 b) {
    u32x4 w = {cvtpk(a[0], a[1]), cvtpk(a[2], a[3]), cvtpk(b[0], b[1]), cvtpk(b[2], b[3])};
    return *reinterpret_cast<bf16x8*>(&w);
}
template <class T> __device__ __forceinline__ bf16x8 load8(const T* p) {
    if constexpr (same_t<T, float>::v) { return pack8(*(const f32x4*)p, *(const f32x4*)(p + 4)); }
    else { return *reinterpret_cast<const bf16x8*>(p); }
}
__device__ __forceinline__ void mask_tile(f32x16& p0, f32x16& p1, int dq, unsigned W) {
    const float NEG = -__builtin_inff();
#pragma unroll
    for (int r = 0; r < 16; ++r) {
        const int c = (r & 3) + 8 * (r >> 2);
        if ((unsigned)(dq - c) >= W) p0[r] = NEG;
        if ((unsigned)(dq - c - 32) >= W) p1[r] = NEG;
    }
}
__device__ __forceinline__ void partialSM(f32x16& p0, f32x16& p1, float& m_reg, float& mn, float& alpha) {
    float pmax = p0[0]; for (int r = 1; r < 16; ++r) pmax = fmaxf(pmax, p0[r]); for (int r = 0; r < 16; ++r) pmax = fmaxf(pmax, p1[r]);
    { auto rr = __builtin_amdgcn_permlane32_swap(__float_as_uint(pmax), __float_as_uint(pmax), false, false);
      pmax = fmaxf(__uint_as_float(rr[0]), __uint_as_float(rr[1])); }
    constexpr float C2 = 1.4426950408889634f * SCALE;
    if (__builtin_expect(__all((pmax - m_reg) * SCALE <= THR), 1)) { mn = m_reg; alpha = 1.f; }
    else { mn = fmaxf(m_reg, pmax); alpha = __builtin_amdgcn_exp2f((m_reg - mn) * C2); m_reg = mn; }
    const float mnL = -mn * C2;
    for (int r = 0; r < 16; ++r) p0[r] = fmaf(p0[r], C2, mnL); for (int r = 0; r < 16; ++r) p1[r] = fmaf(p1[r], C2, mnL);
    for (int r = 0; r < 16; ++r) p0[r] = __builtin_amdgcn_exp2f(p0[r]);
}
__device__ __forceinline__ void finishSM(f32x16& p0, f32x16& p1, float alpha, float& l_reg, bf16x8& pa0, bf16x8& pa1, bf16x8& pa2, bf16x8& pa3) {
    for (int r = 0; r < 16; ++r) p1[r] = __builtin_amdgcn_exp2f(p1[r]);
    float ps = 0; for (int r = 0; r < 16; ++r) ps += p0[r]; for (int r = 0; r < 16; ++r) ps += p1[r];
    { auto rr = __builtin_amdgcn_permlane32_swap(__float_as_uint(ps), __float_as_uint(ps), false, false);
      ps = __uint_as_float(rr[0]) + __uint_as_float(rr[1]); }
    l_reg = l_reg * alpha + ps;
#define PK4(P, B_, OUT) do { unsigned a0 = cvtpk(P[B_+0], P[B_+1]), a1 = cvtpk(P[B_+2], P[B_+3]);                          \
        unsigned b0 = cvtpk(P[B_+4], P[B_+5]), b1 = cvtpk(P[B_+6], P[B_+7]);                                             \
        auto r0 = __builtin_amdgcn_permlane32_swap(a0, b0, false, false); auto r1 = __builtin_amdgcn_permlane32_swap(a1, b1, false, false); \
        u32x4 w = {r0[0], r1[0], r0[1], r1[1]}; OUT = *reinterpret_cast<bf16x8*>(&w); } while (0)
    PK4(p0, 0, pa0); PK4(p0, 8, pa1); PK4(p1, 0, pa2); PK4(p1, 8, pa3);
#undef PK4
}
template <int KB, bool SK>
__device__ __forceinline__ void qkt(f32x16& p0, f32x16& p1, const lchar* K_lds, int r32, int hi, const lchar* qsl, const bf16x8* qh, bool act, const lchar* csb, float cqs) {
    if (SK && !act) { const float NEG = -__builtin_inff();
#pragma unroll
        for (int r = 0; r < 16; ++r) { p0[r] = NEG; p1[r] = NEG; } return; }
    { const LDSA f32x4* cb = (const LDSA f32x4*)csb;
#pragma unroll
      for (int j = 0; j < 4; ++j) { const f32x4 a = cb[2 * j], b = cb[2 * j + 8];
#pragma unroll
          for (int e = 0; e < 4; ++e) { p0[4 * j + e] = cqs - a[e]; p1[4 * j + e] = cqs - b[e]; } } }
    const lchar* kb[4];
#pragma unroll
    for (int dd = 0; dd < 4; ++dd) kb[dd] = K_lds + KB * SHM_K + KSWZ(r32, (dd * 16 + hi * 8) * 2);
#pragma unroll
    for (int d0 = 0; d0 < 8; ++d0) { const lchar* a = kb[d0 & 3] + (d0 >> 2) * 128;
        bf16x8 b0 = *(const LDSA bf16x8*)(a);
        bf16x8 b1 = *(const LDSA bf16x8*)(a + 32 * 256);
        const bf16x8 qf = (d0 < QREG) ? qh[d0] : *(const LDSA bf16x8*)(qsl + d0 * 1024);
        p0 = __builtin_amdgcn_mfma_f32_32x32x16_bf16(b0, qf, p0, 0, 0, 0);
        p1 = __builtin_amdgcn_mfma_f32_32x32x16_bf16(b1, qf, p1, 0, 0, 0); }
}
template <int VB, bool SK>
__device__ __forceinline__ void pv_tile(f32x16* o, int vb0, bf16x8 pa0, bf16x8 pa1, bf16x8 pa2, bf16x8 pa3, bool act) {
    if (SK && !act) return;
#define TRRD(dst, off) asm volatile("ds_read_b64_tr_b16 %0, %1 offset:%2" : "=&v"(dst) : "v"(vb0), "i"(off) : "memory")
#define PV_D0(d0) do { s16x4 l0, l1, l2, l3, h0, h1, h2, h3; constexpr int b_ = VB * SHM_V + v_rd_off(d0, 0, 0);     \
        TRRD(l0, b_); TRRD(h0, b_ + 2048); TRRD(l1, b_ + 4096); TRRD(h1, b_ + 6144); TRRD(l2, b_ + 8192); TRRD(h2, b_ + 10240); TRRD(l3, b_ + 12288); TRRD(h3, b_ + 14336); \
        asm volatile("s_waitcnt lgkmcnt(0)" ::: "memory"); SBAR();                 \
        o[d0] = __builtin_amdgcn_mfma_f32_32x32x16_bf16(pa0, (bf16x8){l0[0], l0[1], l0[2], l0[3], h0[0], h0[1], h0[2], h0[3]}, o[d0], 0, 0, 0);   \
        o[d0] = __builtin_amdgcn_mfma_f32_32x32x16_bf16(pa1, (bf16x8){l1[0], l1[1], l1[2], l1[3], h1[0], h1[1], h1[2], h1[3]}, o[d0], 0, 0, 0);   \
        o[d0] = __builtin_amdgcn_mfma_f32_32x32x16_bf16(pa2, (bf16x8){l2[0], l2[1], l2[2], l2[3], h2[0], h2[1], h2[2], h2[3]}, o[d0], 0, 0, 0);   \
        o[d0] = __builtin_amdgcn_mfma_f32_32x32x16_bf16(pa3, (bf16x8){l3[0], l3[1], l3[2], l3[3], h3[0], h3[1], h3[2], h3[3]}, o[d0], 0, 0, 0); } while (0)
    PV_D0(0); PV_D0(1); PV_D0(2); PV_D0(3);
#undef PV_D0
#undef TRRD
}

template <class TIn, class TOut> struct BlockRef { const TIn* Q; const TIn* K; const TIn* V; TOut* O; const TOut* OI; const float* CS; int P0; };
template <class TIn> struct Seam {
    bf16x8 qr[8];
    bf16x8 st_v0, st_v1, st_k0, st_k1; f32x4 sf0, sf1, sf2, sf3;
    f32x4 tq[16];
    f32x4 csv;
};
__device__ __forceinline__ int swa_jlo(int P0, int W) { const int lowk = P0 - W + 1; return lowk > 0 ? lowk / KVBLK : 0; }
__device__ __forceinline__ int swa_jhi(int P0, int skv) { int j = (P0 + QB - 1) / KVBLK + 1; return j > skv / KVBLK ? skv / KVBLK : j; }
#define ROW(p, k0, rr) ((p) + (size_t)((k0) + (rr)) * D + sc)
#define VMW() asm volatile("s_waitcnt vmcnt(0)" ::: "memory")
#define VMWN(n) asm volatile("s_waitcnt vmcnt(%0)" :: "i"(n) : "memory")
#define SLOAD_H(Kp, Vp, k0) do { S.st_v0 = load8<TIn>(ROW(Vp, k0, sr)); S.st_v1 = load8<TIn>(ROW(Vp, k0, 32 + sr));              \
                         S.st_k0 = load8<TIn>(ROW(Kp, k0, sr)); S.st_k1 = load8<TIn>(ROW(Kp, k0, 32 + sr)); } while (0)
#define SWRITE_HK(bf) do { *(LDSA bf16x8*)(K_lds + (bf) * SHM_K + kws) = S.st_k0; *(LDSA bf16x8*)(K_lds + (bf) * SHM_K + kws + 32 * 256) = S.st_k1; } while (0)
#define SWRITE_HV(bf) do { *(LDSA bf16x8*)(V_lds + (bf) * SHM_V + vst0) = S.st_v0; *(LDSA bf16x8*)(V_lds + (bf) * SHM_V + vst1) = S.st_v1; } while (0)
#define SWRITE_H(bf) do { SWRITE_HV(bf); SWRITE_HK(bf); } while (0)
#define SLOAD_F(p, k0) do { S.sf0 = *(const f32x4*)ROW(p, k0, sr); S.sf1 = *(const f32x4*)(ROW(p, k0, sr) + 4);                \
                            S.sf2 = *(const f32x4*)ROW(p, k0, 32 + sr); S.sf3 = *(const f32x4*)(ROW(p, k0, 32 + sr) + 4); } while (0)
#define SWRITE_KF(bf) do { *(LDSA bf16x8*)(K_lds + (bf) * SHM_K + kws) = pack8(S.sf0, S.sf1); *(LDSA bf16x8*)(K_lds + (bf) * SHM_K + kws + 32 * 256) = pack8(S.sf2, S.sf3); } while (0)
#define SWRITE_VF(bf) do { *(LDSA bf16x8*)(V_lds + (bf) * SHM_V + vst0) = pack8(S.sf0, S.sf1); *(LDSA bf16x8*)(V_lds + (bf) * SHM_V + vst1) = pack8(S.sf2, S.sf3); } while (0)
template <class TIn, class TOut>
__device__ __forceinline__ void causal_swa_prime(const BlockRef<TIn, TOut>& cur, int W, lchar* lds, Seam<TIn>& S) {
    constexpr bool F32 = same_t<TIn, float>::v;
    const int tid = ltid(), wid = __builtin_amdgcn_readfirstlane(tid >> 6), lane = tid & 63, r32 = lane & 31, hi = lane >> 5;
    const int sr = tid >> 4, sc = (tid & 15) * 8, kws = KSWZ(sr, sc * 2); lchar* K_lds = lds + 2 * SHM_V;
    const int kb0 = (swa_jhi(cur.P0, SKV) - 1) * KVBLK;
    for (int d0 = 0; d0 < 8; ++d0) S.qr[d0] = load8<TIn>(cur.Q + (size_t)(wid * QBLK + r32) * D + d0 * 16 + hi * 8);
    if constexpr (F32) { SLOAD_F((const float*)cur.K, kb0); VMW(); SWRITE_KF(0); SBAR(); SLOAD_F((const float*)cur.V, kb0); }
    else { SLOAD_H(cur.K, cur.V, kb0); S.csv = *(const f32x4*)(cur.CS + 4 * tid); VMW(); SWRITE_HK(0); *(LDSA f32x4*)(lds + CS_OFF + 16 * tid) = S.csv; }
    __syncthreads();
}
template <class TIn, class TOut>
__device__ __forceinline__ void causal_swa_block(const BlockRef<TIn, TOut>& cur, const BlockRef<TIn, TOut>& nxt, int skv, int W, lchar* lds, Seam<TIn>& S) {
    constexpr bool F32 = same_t<TIn, float>::v;
    const int tid = ltid(), wid = __builtin_amdgcn_readfirstlane(tid >> 6), lane = tid & 63, r32 = lane & 31, hi = lane >> 5;
    const int j_lo = swa_jlo(cur.P0, W);
    int j_hi = (cur.P0 + QB - 1) / KVBLK + 1; if (j_hi > skv / KVBLK) j_hi = skv / KVBLK;
    const int NT = j_hi - j_lo;
    const int kbn = (swa_jhi(nxt.P0, skv) - 1) * KVBLK;
    const int qlo = cur.P0 + wid * QBLK, qm = qlo + r32 - 4 * hi;
    lchar* V_lds = lds; lchar* K_lds = lds + 2 * SHM_V;
    LDSA float* ws = (LDSA float*)(lds + 2 * SHM_V + 2 * SHM_K) + wid * 64; LDSA float* li_l = ws; LDSA float* al_l = ws + 32;
    float m_reg = -1e30f, l_reg = 0; f32x16 o[4] = {};
    const lchar* cs_lds = lds + CS_OFF; const float cqs = ((const LDSA float*)cs_lds)[cur.P0 + wid * QBLK + r32]; const lchar* csl = cs_lds + hi * 16;
    lchar* qsl = lds + QS_OFF + wid * 8192 + lane * 16;
#pragma unroll
    for (int d0 = QREG; d0 < 8; ++d0) *(LDSA bf16x8*)(qsl + d0 * 1024) = S.qr[d0];
    bf16x8 qh[QREG > 0 ? QREG : 1];
#pragma unroll
    for (int d0 = 0; d0 < QREG; ++d0) qh[d0] = S.qr[d0];
    const int sr = tid >> 4, sc = (tid & 15) * 8, vst0 = v_st(sr, sc), vst1 = v_st(32 + sr, sc), kws = KSWZ(sr, sc * 2);
    const int vb0 = (int)(uintptr_t)V_lds + v_rd_base(lane);
    const TIn* Kh = cur.K; const TIn* Vh = cur.V;
#define RESC(a) do { if (__any((a) < 1.f)) { if (hi == 0) al_l[r32] = (a); asm volatile("s_waitcnt lgkmcnt(0)" ::: "memory");              \
                     for (int d_ = 0; d_ < 4; ++d_) for (int r = 0; r < 16; ++r) o[d_][r] *= al_l[crow(r, hi)]; } } while (0)
#define KBASE(t) ((j_hi - 1 - (t)) * KVBLK)
#define ACT(t) (KBASE(t) <= qlo + QBLK - 1 && KBASE(t) + KVBLK - 1 >= qlo - W + 1)
#define MASKT(P0_, P1_, t) do { const int kb_ = KBASE(t); if ((!SK || ACT(t)) && (kb_ + KVBLK - 1 > qlo || kb_ <= qlo + QBLK - 1 - W)) mask_tile(P0_, P1_, qm - kb_, (unsigned)W); } while (0)
    constexpr int NQL = F32 ? 16 : 8;
    constexpr bool SK = WSKIP && !F32;
#define SEAM_K0() do { VMWN(NQL); if constexpr (F32) { SWRITE_KF(0); SBAR(); SLOAD_F((const float*)nxt.V, kbn); } else { SWRITE_HK(0); *(LDSA f32x4*)(lds + CS_OFF + 16 * tid) = S.csv; } SBAR(); } while (0)
    f32x16 pA0, pA1, pB0, pB1; float mnA, mnB, alA, alB; bf16x8 pa0, pa1, pa2, pa3;
    if constexpr (F32) { VMW(); SWRITE_VF(0); SBAR(); } else { SWRITE_HV(0); SBAR(); }
    if (NT > 1) { if constexpr (F32) SLOAD_F((const float*)Kh, KBASE(1)); else SLOAD_H(Kh, Vh, KBASE(1)); }
    SBAR(); qkt<0, SK>(pA0, pA1, K_lds, r32, hi, qsl, qh, ACT(0), csl + KBASE(0) * 4, cqs);
    if constexpr (F32) { if (NT > 1) { VMW(); SWRITE_KF(1); SBAR(); SLOAD_F((const float*)Vh, KBASE(1)); } }
    MASKT(pA0, pA1, 0); partialSM(pA0, pA1, m_reg, mnA, alA);
    if (NT > 1) { VMW(); if constexpr (F32) { SWRITE_VF(1); SBAR(); if (NT > 2) SLOAD_F((const float*)Kh, KBASE(2)); } else SWRITE_H(1); }
    __syncthreads();
#define HALF_STEP(PX0, PX1, mnX, alX, PY0, PY1, alY, t, KB, VB, SB) do {                                                      \
        SBAR(); qkt<KB, SK>(PX0, PX1, K_lds, r32, hi, qsl, qh, ACT(t), csl + KBASE(t) * 4, cqs);                                             \
        finishSM(PY0, PY1, alY, l_reg, pa0, pa1, pa2, pa3); SBAR();                                                           \
        if ((t) + 1 < NT) { if constexpr (F32) { VMW(); SWRITE_KF(SB); SBAR(); SLOAD_F((const float*)Vh, KBASE((t) + 1)); }  \
                            else { SLOAD_H(Kh, Vh, KBASE((t) + 1)); } SBAR(); }                                               \
        pv_tile<VB, SK>(o, vb0, pa0, pa1, pa2, pa3, ACT((t) - 1)); MASKT(PX0, PX1, (t)); partialSM(PX0, PX1, m_reg, mnX, alX);                                        \
        __syncthreads();                                                                                                      \
        if ((t) + 1 < NT) { VMW(); if constexpr (F32) { SWRITE_VF(SB); SBAR(); if ((t) + 2 < NT) SLOAD_F((const float*)Kh, KBASE((t) + 2)); } \
                            else { SWRITE_H(SB); } }                                                                          \
        RESC(alX); __syncthreads(); } while (0)
    for (int t = 1; t + 1 < NT; t += 2) {
        HALF_STEP(pB0, pB1, mnB, alB, pA0, pA1, alA, t, 1, 0, 0);
        HALF_STEP(pA0, pA1, mnA, alA, pB0, pB1, alB, t + 1, 0, 1, 1);
    }
    const bool even = (NT & 1) == 0;
    if (even) { SBAR(); qkt<1, SK>(pB0, pB1, K_lds, r32, hi, qsl, qh, ACT(NT - 1), csl + KBASE(NT - 1) * 4, cqs); SBAR(); }
#define QROW(e) (nxt.Q + (size_t)(wid * QBLK + r32) * D + ((e) >> 1) * 16 + hi * 8 + ((e) & 1) * 4)
    if constexpr (F32) { SLOAD_F((const float*)nxt.K, kbn); SBAR();
#pragma unroll
        for (int e = 0; e < 8; ++e) S.tq[e] = *(const f32x4*)QROW(e); }
    else { S.csv = *(const f32x4*)(nxt.CS + 4 * tid); SLOAD_H(nxt.K, nxt.V, kbn); SBAR();
#pragma unroll
        for (int d0 = 0; d0 < 8; ++d0) S.qr[d0] = load8<TIn>(nxt.Q + (size_t)(wid * QBLK + r32) * D + d0 * 16 + hi * 8); }
    SBAR();
    finishSM(pA0, pA1, alA, l_reg, pa0, pa1, pa2, pa3); SBAR();
    if constexpr (F32) {
#pragma unroll
        for (int e = 8; e < 16; ++e) S.tq[e] = *(const f32x4*)QROW(e); SBAR(); }
#undef QROW
    pv_tile<0, SK>(o, vb0, pa0, pa1, pa2, pa3, ACT(even ? NT - 2 : NT - 1));
    if (even) { MASKT(pB0, pB1, NT - 1); partialSM(pB0, pB1, m_reg, mnB, alB); __syncthreads(); RESC(alB);
        finishSM(pB0, pB1, alB, l_reg, pa0, pa1, pa2, pa3); SBAR(); pv_tile<1, SK>(o, vb0, pa0, pa1, pa2, pa3, ACT(NT - 1)); }
    SBAR(); SEAM_K0();
    if (hi == 0) li_l[r32] = l_reg; asm volatile("s_waitcnt lgkmcnt(0)" ::: "memory");
    float rli[16];
#pragma unroll
    for (int r = 0; r < 16; ++r) rli[r] = __builtin_amdgcn_rcpf(li_l[crow(r, hi)]);
    TOut* Ow = cur.O + (size_t)(wid * QBLK) * OLD; const TOut* OIw = cur.OI + (size_t)(wid * QBLK) * OLD;
#pragma unroll
    for (int r = 0; r < 16; ++r) { const int orow = crow(r, hi);
#pragma unroll
        for (int d0 = 0; d0 < 4; ++d0) { const float v = o[d0][r] * rli[r];
            if constexpr (same_t<TOut, float>::v) { Ow[(size_t)orow * OLD + d0 * 32 + r32] = v; }
            else { const float vn = __shfl_xor(v, 1);
                   if ((r32 & 1) == 0) { const size_t eo = (size_t)orow * OLD + d0 * 32 + r32; unsigned* pp = (unsigned*)(Ow + eo); const unsigned sp = *(const unsigned*)(OIw + eo);
                       *pp = cvtpk(v * __uint_as_float(sp << 16), vn * __uint_as_float(sp & 0xffff0000u)); } } } }
    if constexpr (F32) {
#pragma unroll
        for (int d0 = 0; d0 < 8; ++d0) S.qr[d0] = pack8(S.tq[2 * d0], S.tq[2 * d0 + 1]); }
    __syncthreads();
#undef RESC
#undef KBASE
#undef ACT
#undef MASKT
#undef SEAM_K0
#undef HALF_STEP
}
#undef ROW
#undef VMW
#undef VMWN
#undef SLOAD_H
#undef SWRITE_HK
#undef SWRITE_HV
#undef SWRITE_H
#undef SLOAD_F
#undef SWRITE_KF
#undef SWRITE_VF

}
namespace mk {
typedef unsigned short bf16_t;
typedef float f32x4 __attribute__((ext_vector_type(4)));
typedef float f32x2 __attribute__((ext_vector_type(2)));
typedef unsigned u32x4 __attribute__((ext_vector_type(4)));
typedef unsigned u32x2 __attribute__((ext_vector_type(2)));
typedef short bf16x8 __attribute__((ext_vector_type(8)));
typedef float f32x16 __attribute__((ext_vector_type(16)));
#define LAS __attribute__((address_space(3)))
typedef LAS float __attribute__((may_alias)) f32_ma;
typedef LAS unsigned short __attribute__((may_alias)) u16_ma;
typedef LAS unsigned __attribute__((may_alias)) u32_ma;
typedef LAS bf16x8 __attribute__((may_alias)) bf16x8_ma;
constexpr int MTOK = 8192, DM = 2048, SEQ = 2048;
constexpr int LDS_BYTES = 147456;
constexpr int NPHASE = 17;
constexpr size_t MiB = 1u << 20, KiB = 1u << 10;
constexpr size_t WS_W_S5IN = 0, WS_W_FOXIN = 32 * MiB, WS_W_POOLIN = 64 * MiB, WS_W_OUT = 80 * MiB, WS_W_GLU = 112 * MiB, WS_W_POOLG = 128 * MiB;
constexpr size_t WS_MISC = 130 * MiB, WS_HB = 136 * MiB, WS_U = 168 * MiB, WS_K = 200 * MiB, WS_V = 232 * MiB, WS_SZ = 264 * MiB, WS_HL = 296 * MiB, WS_END = (RESID_MODE == 2 ? 328 : 296) * MiB;
static_assert(WS_K - WS_U == 32 * MiB && WS_V - WS_K == 32 * MiB && WS_SZ - WS_V == 32 * MiB, "Epi::OSTR");
constexpr size_t MS_SSQ = 4096 * KiB  , MS_FLOG = 128 * KiB, MS_CS = 640 * KiB, MS_WF = 1152 * KiB, MS_ABAR = 1280 * KiB, MS_BBAR = 1408 * KiB, MS_CM = 2432 * KiB, MS_BAR = 3456 * KiB, BAR_BYTES = 49152;
struct Params { const float* in[21]; float* out; unsigned char* ws; int ph_lo, ph_hi; };

__device__ __forceinline__ unsigned f2bf(float f) { unsigned u = __float_as_uint(f); return (u + 0x7fffu + ((u >> 16) & 1u)) >> 16; }
__device__ __forceinline__ unsigned pk2(float lo, float hi) { return f2bf(lo) | (f2bf(hi) << 16); }
__device__ __forceinline__ float wave_sum(float v) {
#pragma unroll
    for (int o = 1; o < 64; o <<= 1) v += __shfl_xor(v, o);
    return v;
}
__device__ __forceinline__ int crow(int r, int hi) { return (r & 3) + 8 * (r >> 2) + 4 * hi; }

__device__ __forceinline__ void transpose_item(const float* W, int ldw, int K, int N, const float* kscale, bf16_t* WT, LAS float* scr, int item, int lane) {
    const int nblk = N / 64, kb = item / nblk, nb = item % nblk, k0 = 64 * kb, n0 = 64 * nb, r4 = lane >> 4, c4 = (lane & 15) * 4;
    f32x4 v[16];
#pragma unroll
    for (int i = 0; i < 16; ++i) v[i] = *(const f32x4*)(W + (size_t)(k0 + 4 * i + r4) * ldw + n0 + c4);
    if (kscale) {
#pragma unroll
        for (int i = 0; i < 16; ++i) v[i] = v[i] * kscale[k0 + 4 * i + r4]; }
#pragma unroll
    for (int i = 0; i < 16; ++i) { LAS float* d = scr + (4 * i + r4) * 65 + c4; d[0] = v[i][0]; d[1] = v[i][1]; d[2] = v[i][2]; d[3] = v[i][3]; }
    asm volatile("s_waitcnt lgkmcnt(0)" ::: "memory");
    const int c = lane & 7;
#pragma unroll
    for (int j = 0; j < 8; ++j) { const int n = (lane >> 3) + 8 * j; const LAS float* s = scr + (8 * c) * 65 + n;
        u32x4 o; o.x = pk2(s[0 * 65], s[1 * 65]); o.y = pk2(s[2 * 65], s[3 * 65]); o.z = pk2(s[4 * 65], s[5 * 65]); o.w = pk2(s[6 * 65], s[7 * 65]);
        *(u32x4*)(WT + (size_t)(n0 + n) * K + k0 + 8 * c) = o; }
    asm volatile("s_waitcnt lgkmcnt(0)" ::: "memory");
}
__device__ __forceinline__ double exp_small(double x) { double s = 1.0, t = 1.0;
#pragma unroll
    for (int n = 1; n <= 14; ++n) { t *= x * (1.0 / n); s += t; } return s; }
__device__ __forceinline__ double exp_d(double x) { double y = exp_small(x * (1.0 / 64.0));
#pragma unroll
    for (int i = 0; i < 6; ++i) y *= y; return y; }
__device__ __forceinline__ void sincos_d(double th, double& sn, double& cs) {
    const double k = __builtin_rint(th * 0.63661977236758134308);
    const double r = __builtin_fma(-k, 6.123233995736766e-17, __builtin_fma(-k, 1.5707963267948966, th)), r2 = r * r;
    double ts = r, ss = r, tc = 1.0, sc = 1.0;
#pragma unroll
    for (int n = 1; n <= 9; ++n) { tc *= -r2 * (1.0 / ((2 * n - 1) * (2 * n))); sc += tc; ts *= -r2 * (1.0 / ((2 * n) * (2 * n + 1))); ss += ts; }
    const int q = ((int)k) & 3;
    sn = (q == 0) ? ss : (q == 1) ? sc : (q == 2) ? -ss : -sc;
    cs = (q == 0) ? sc : (q == 1) ? -ss : (q == 2) ? -sc : ss;
}
#define PROIN(i) ((const float*)(const __attribute__((address_space(1))) float*)Pk->in[i])
__device__ __forceinline__ void transpose_dispatch(const __attribute__((address_space(4))) Params* Pk, LAS unsigned char* lds, int it, int wid, int lane) {
    unsigned char* ws = (unsigned char*)(__attribute__((address_space(1))) unsigned char*)Pk->ws;
    const float* normw = PROIN(1);
    LAS float* scr = (LAS float*)(lds + wid * 16640);
    int r = it;
    if (r < 4096) { const int j = r >> 11; transpose_item(PROIN(3) + (size_t)j * 2048 * 4096, 4096, 2048, 4096, normw + 3 * j * 2048, (bf16_t*)(ws + WS_W_S5IN) + (size_t)j * 4096 * 2048, scr, r & 2047, lane); return; } r -= 4096;
    if (r < 4096) { transpose_item(PROIN(14), 8208, 2048, 8192, normw + 2048, (bf16_t*)(ws + WS_W_FOXIN), scr, r, lane); return; } r -= 4096;
    if (r < 2048) { transpose_item(PROIN(18), 4096, 2048, 4096, normw + 2 * 2048, (bf16_t*)(ws + WS_W_POOLIN), scr, r, lane); return; } r -= 2048;
    if (r < 4096) { const int i = r >> 10; transpose_item(PROIN(2) + (size_t)i * 2048 * 2048, 2048, 2048, 2048, nullptr, (bf16_t*)(ws + WS_W_OUT) + (size_t)i * 2048 * 2048, scr, r & 1023, lane); return; } r -= 4096;
    if (r < 2048) { const int j = r >> 10; transpose_item(PROIN(12) + (size_t)j * 2048 * 2048, 2048, 2048, 2048, nullptr, (bf16_t*)(ws + WS_W_GLU) + (size_t)j * 2048 * 2048, scr, r & 1023, lane); return; } r -= 2048;
    { const int g = r >> 6; transpose_item(PROIN(19) + (size_t)g * 512 * 512, 512, 512, 512, nullptr, (bf16_t*)(ws + WS_W_POOLG) + (size_t)g * 512 * 512, scr, r & 63, lane); }
}
__device__ __forceinline__ void convert_rest(const __attribute__((address_space(4))) Params* Pk, LAS unsigned char* lds, int k0, int k1, int vb, int vg) {
    const int tid = ltid(), lane = tid & 63, wid = __builtin_amdgcn_readfirstlane(tid >> 6);
    for (int k = k0 + vb * 8 + wid; k < k1; k += vg * 8) {
        int r = k, it;
        if (r < 2048) it = 2048 + r; else { r -= 2048;
        if (r < 4096) it = 4096 + r; else { r -= 4096;
        if (r < 2048) it = 8192 + r; else { r -= 2048;
        if (r < 3072) it = 11264 + r; else { r -= 3072;
        if (r < 1024) it = 15360 + r; else it = 16384 + (r - 1024); } } } }
        transpose_dispatch(Pk, lds, it, wid, lane);
    }
}
__device__ __forceinline__ void prologue(const __attribute__((address_space(4))) Params* Pk, LAS unsigned char* lds) {
    const int tid = ltid(), lane = tid & 63, wid = __builtin_amdgcn_readfirstlane(tid >> 6);
    const int gw = lbid() * 8 + wid, NGW = lgrid() * 8, gt = lbid() * 512 + tid, NGT = lgrid() * 512;
    unsigned char* ws = (unsigned char*)(__attribute__((address_space(1))) unsigned char*)Pk->ws;
    const float* normw = PROIN(1);
    for (int k = gw; k < 4096; k += NGW)
        transpose_dispatch(Pk, lds, k < 2048 ? k : (k < 3072 ? 10240 + (k - 2048) : 14336 + (k - 3072)), wid, lane);
    { float* WF = (float*)(ws + WS_MISC + MS_WF); float* ssq = (float*)(ws + WS_MISC + MS_SSQ);
      bf16_t* WFb = (bf16_t*)WF;
      for (int i = gt; i < 65536; i += NGT) { const int k = i >> 5, h = i & 31; WFb[h * 2048 + k] = h < 16 ? (bf16_t)f2bf(PROIN(14)[(size_t)k * 8208 + 8192 + h] * normw[2048 + k]) : (bf16_t)0; }
      (void)ssq; }
    { bf16_t* HB = (bf16_t*)(ws + WS_HB); float* ssq = (float*)(ws + WS_MISC + MS_SSQ); const float* x = PROIN(0);
      for (int m = gw; m < MTOK; m += NGW) { const f32x4* xr = (const f32x4*)(x + (size_t)m * DM) + lane; float s = 0.f; u32x2* o = (u32x2*)(HB + (size_t)m * DM) + lane;
#pragma unroll
          for (int j = 0; j < 8; ++j) { const f32x4 v = xr[64 * j]; s += (v.x * v.x + v.y * v.y) + (v.z * v.z + v.w * v.w); o[64 * j] = (u32x2){pk2(v.x, v.y), pk2(v.z, v.w)}; }
          s = wave_sum(s); if (lane < 8) ssq[(size_t)m * 8 + lane] = lane == 0 ? s : 0.f; } }
    { float* abar = (float*)(ws + WS_MISC + MS_ABAR); bf16_t* bbarT = (bf16_t*)(ws + WS_MISC + MS_BBAR); bf16_t* cmT = (bf16_t*)(ws + WS_MISC + MS_CM);
      for (int it = gw; it < 256; it += NGW) { const int jg = it, p = lane;
          const double dt = exp_d((double)PROIN(6)[jg]);
          const double ar = (double)PROIN(4)[jg * 64 + p], ai = (double)PROIN(5)[jg * 64 + p];
          const double mag = exp_d(ar * dt); double sn, cs; sincos_d(ai * dt, sn, cs);
          const double abr = mag * cs, abi = mag * sn, den = ar * ar + ai * ai, xr = abr - 1.0;
          const double fr = (xr * ar + abi * ai) / den, fi = (abi * ar - xr * ai) / den;
          abar[(jg * 64 + p) * 2] = (float)abr; abar[(jg * 64 + p) * 2 + 1] = (float)abi;
          const float* br = PROIN(7) + (size_t)(jg * 64 + p) * 16; const float* bi = PROIN(8) + (size_t)(jg * 64 + p) * 16;
          unsigned wr_[8], wi_[8];
#pragma unroll
          for (int c = 0; c < 8; ++c) { const double r0 = br[2 * c], i0 = bi[2 * c], r1 = br[2 * c + 1], i1 = bi[2 * c + 1];
              wr_[c] = pk2((float)(fr * r0 - fi * i0), (float)(fr * r1 - fi * i1)); wi_[c] = pk2((float)(fr * i0 + fi * r0), (float)(fr * i1 + fi * r1)); }
          u32x4* dr = (u32x4*)(bbarT + ((size_t)jg * 128 + p) * 16); u32x4* di = (u32x4*)(bbarT + ((size_t)jg * 128 + 64 + p) * 16);
          dr[0] = (u32x4){wr_[0], wr_[1], wr_[2], wr_[3]}; dr[1] = (u32x4){wr_[4], wr_[5], wr_[6], wr_[7]};
          di[0] = (u32x4){wi_[0], wi_[1], wi_[2], wi_[3]}; di[1] = (u32x4){wi_[4], wi_[5], wi_[6], wi_[7]};
#pragma unroll
          for (int c = 0; c < 16; ++c) { const size_t ci = ((size_t)jg * 16 + c) * 64 + p;
              ((unsigned*)cmT)[((size_t)jg * 16 + c) * 64 + p] = pk2(PROIN(9)[ci], -PROIN(10)[ci]); }
      } }
}

__device__ __forceinline__ float gelu_tanh(float x) { const float p = __builtin_fmaf(x * x, -0.10294324f, -2.30220819f); return x * __builtin_amdgcn_rcpf(1.f + __builtin_amdgcn_exp2f(p * x)); }
typedef LAS f32x4 __attribute__((may_alias)) f32x4_ma;
template <bool OUT>
__device__ __forceinline__ void s5_chunks(LAS unsigned char* buf, const bf16_t* Ug, bf16_t* Gg, const bf16x8 (&bfrag)[4], const bf16x8 (&cfrag)[8], const f32x4 da, const f32x4 db,
                                          float ar, float ai, float& hr, float& hi_, int lane, int r32, int hi) {
    LAS unsigned char* Hb = buf + 8192;
    const int swz = (lane >> 2) & 3, wsw = (r32 >> 2) & 3;
    const LAS unsigned char* rre = buf + lane * 64; const LAS unsigned char* rim = buf + (64 + lane) * 64;
    bf16x8 a_nx = *(const bf16x8*)(Ug + (size_t)r32 * DM + hi * 8);
    for (int c = 0; c < 16; ++c) {
        const bf16x8 a = a_nx;
        if (c + 1 < 16) a_nx = *(const bf16x8*)(Ug + (size_t)((c + 1) * 32 + r32) * DM + hi * 8);
        const size_t ro = (size_t)(c * 32 + r32) * DM + 4 * hi;
        u32x2 ua = {0u, 0u}, ub = {0u, 0u};
        if (OUT) { ua = *(const u32x2*)(Ug + ro); ub = *(const u32x2*)(Ug + ro + 8); }
        f32x16 d[4];
#pragma unroll
        for (int jt = 0; jt < 4; ++jt) { d[jt] = f32x16{}; d[jt] = __builtin_amdgcn_mfma_f32_32x32x16_bf16(a, bfrag[jt], d[jt], 0, 0, 0); }
#pragma unroll
        for (int hh = 0; hh < 2; ++hh) {
#pragma unroll
            for (int jt = 0; jt < 4; ++jt)
#pragma unroll
                for (int rg = 0; rg < 2; ++rg) { const int r0 = 8 * hh + 4 * rg;
                    *(f32x4_ma*)(buf + (jt * 32 + r32) * 64 + (((2 * rg + hi) ^ wsw) * 16)) = (f32x4){d[jt][r0], d[jt][r0 + 1], d[jt][r0 + 2], d[jt][r0 + 3]}; }
            f32x4 R[4], I[4];
#pragma unroll
            for (int j = 0; j < 4; ++j) { R[j] = *(const f32x4_ma*)(rre + ((j ^ swz) * 16)); I[j] = *(const f32x4_ma*)(rim + ((j ^ swz) * 16)); }
#pragma unroll
            for (int q = 0; q < 4; ++q) {
                LAS unsigned char* rw = Hb + (16 * hh + 4 * q) * 272;
#pragma unroll
                for (int k = 0; k < 4; ++k) {
                    const float nr = __builtin_fmaf(ar, hr, __builtin_fmaf(-ai, hi_, R[q][k])), ni = __builtin_fmaf(ar, hi_, __builtin_fmaf(ai, hr, I[q][k])); hr = nr; hi_ = ni;
                    if (OUT) ((u32_ma*)(rw + 272 * k))[lane] = pg8::cvt_pk_bf16(hr, hi_);
                }
            }
        }
        if (OUT) {
            f32x16 y = {};
#pragma unroll
            for (int kk = 0; kk < 8; ++kk) { const bf16x8 hf = *(const bf16x8_ma*)(Hb + r32 * 272 + (kk * 16 + hi * 8) * 2); y = __builtin_amdgcn_mfma_f32_32x32x16_bf16(cfrag[kk], hf, y, 0, 0, 0); }
            const float a0 = gelu_tanh(y[0] + da[0] * pg8::bf_lo(ua.x)), a1 = gelu_tanh(y[1] + da[1] * pg8::bf_hi(ua.x)), a2 = gelu_tanh(y[2] + da[2] * pg8::bf_lo(ua.y)), a3 = gelu_tanh(y[3] + da[3] * pg8::bf_hi(ua.y));
            const float b0 = gelu_tanh(y[4] + db[0] * pg8::bf_lo(ub.x)), b1 = gelu_tanh(y[5] + db[1] * pg8::bf_hi(ub.x)), b2 = gelu_tanh(y[6] + db[2] * pg8::bf_lo(ub.y)), b3 = gelu_tanh(y[7] + db[3] * pg8::bf_hi(ub.y));
            *(u32x2*)(Gg + ro) = (u32x2){pg8::cvt_pk_bf16(a0, a1), pg8::cvt_pk_bf16(a2, a3)}; *(u32x2*)(Gg + ro + 8) = (u32x2){pg8::cvt_pk_bf16(b0, b1), pg8::cvt_pk_bf16(b2, b3)};
        }
    }
}
__device__ __forceinline__ void s5_pass1_direct(const bf16_t* Ug, const bf16x8 (&bfrag)[4], const float* abg  , float& hr, float& hi_, int lane, int r32, int hi) {
    float wr[2][16], wi[2][16], a32r[2], a32i[2];
#pragma unroll
    for (int s = 0; s < 2; ++s) {
        const float ar = abg[(32 * s + r32) * 2], ai = abg[(32 * s + r32) * 2 + 1];
        float pr[32], pi[32]; pr[0] = 1.f; pi[0] = 0.f;
#pragma unroll
        for (int k = 1; k < 32; ++k) { pr[k] = pr[k - 1] * ar - pi[k - 1] * ai; pi[k] = pr[k - 1] * ai + pi[k - 1] * ar; }
        a32r[s] = pr[31] * ar - pi[31] * ai; a32i[s] = pr[31] * ai + pi[31] * ar;
#pragma unroll
        for (int r = 0; r < 16; ++r) { const int k0 = 31 - (r & 3) - 8 * (r >> 2); wr[s][r] = hi ? pr[k0 - 4] : pr[k0]; wi[s][r] = hi ? pi[k0 - 4] : pi[k0]; }
    }
    float Er[2] = {0.f, 0.f}, Ei[2] = {0.f, 0.f};
    bf16x8 a_nx = *(const bf16x8*)(Ug + (size_t)r32 * DM + hi * 8);
    for (int c = 0; c < 16; ++c) {
        const bf16x8 a = a_nx;
        if (c + 1 < 16) a_nx = *(const bf16x8*)(Ug + (size_t)((c + 1) * 32 + r32) * DM + hi * 8);
        f32x16 d[4];
#pragma unroll
        for (int jt = 0; jt < 4; ++jt) { d[jt] = f32x16{}; d[jt] = __builtin_amdgcn_mfma_f32_32x32x16_bf16(a, bfrag[jt], d[jt], 0, 0, 0); }
#pragma unroll
        for (int s = 0; s < 2; ++s) {
            float er = 0.f, ei = 0.f;
#pragma unroll
            for (int r = 0; r < 16; ++r) { const float br = d[s][r], bi = d[2 + s][r];
                er = __builtin_fmaf(wr[s][r], br, __builtin_fmaf(-wi[s][r], bi, er)); ei = __builtin_fmaf(wr[s][r], bi, __builtin_fmaf(wi[s][r], br, ei)); }
            { auto r0 = __builtin_amdgcn_permlane32_swap(__float_as_uint(er), __float_as_uint(er), false, false); er = __uint_as_float(r0[0]) + __uint_as_float(r0[1]);
              auto r1 = __builtin_amdgcn_permlane32_swap(__float_as_uint(ei), __float_as_uint(ei), false, false); ei = __uint_as_float(r1[0]) + __uint_as_float(r1[1]); }
            const float nr = __builtin_fmaf(a32r[s], Er[s], __builtin_fmaf(-a32i[s], Ei[s], er)), ni = __builtin_fmaf(a32r[s], Ei[s], __builtin_fmaf(a32i[s], Er[s], ei)); Er[s] = nr; Ei[s] = ni;
        }
    }
    hr = lane < 32 ? Er[0] : Er[1]; hi_ = lane < 32 ? Ei[0] : Ei[1];
}
__device__ __forceinline__ void s5_phase(LAS unsigned char* lds, const bf16_t* U, bf16_t* G, const float* abar, const bf16_t* bbarT, const bf16_t* cmT, const float* dskip, int p0, int p1, int pstride) {
    const int tid = ltid(), lane = tid & 63, wid = __builtin_amdgcn_readfirstlane(tid >> 6), r32 = lane & 31, hi = lane >> 5;
    LAS unsigned char* buf = lds + wid * 16896; f32_ma* ex = (f32_ma*)(lds + 8 * 16896);
    for (int pair = p0; pair < p1; pair += pstride) {
        const int bg = pair * 2 + (wid >> 2), seg = wid & 3, b = bg >> 7, g = bg & 127;
        const float ar = abar[(g * 64 + lane) * 2], ai = abar[(g * 64 + lane) * 2 + 1];
        bf16x8 bfrag[4], cfrag[8];
#pragma unroll
        for (int jt = 0; jt < 4; ++jt) bfrag[jt] = *(const bf16x8*)(bbarT + ((size_t)g * 128 + jt * 32 + r32) * 16 + hi * 8);
        const size_t rowbase = (size_t)b * SEQ + seg * 512;
        const bf16_t* Ug = U + rowbase * DM + g * 16; bf16_t* Gg = G + rowbase * DM + g * 16;
        float hr = 0.f, hi_ = 0.f;
        if (seg != 3) s5_pass1_direct(Ug, bfrag, abar + (size_t)g * 64 * 2, hr, hi_, lane, r32, hi);
        ex[(wid * 64 + lane) * 2] = hr; ex[(wid * 64 + lane) * 2 + 1] = hi_;
        __syncthreads();
        asm volatile("" ::: "memory");
#pragma unroll
        for (int kk = 0; kk < 8; ++kk) { cfrag[kk] = (bf16x8){0, 0, 0, 0, 0, 0, 0, 0}; if (r32 < 16) cfrag[kk] = *(const bf16x8*)(cmT + ((size_t)g * 16 + r32) * 128 + kk * 16 + hi * 8); }
        const f32x4 da = *(const f32x4*)(dskip + g * 16 + 4 * hi), db = *(const f32x4*)(dskip + g * 16 + 8 + 4 * hi);
        float pr = ar, pi = ai;
#pragma unroll
        for (int i = 0; i < 9; ++i) { const float nr = pr * pr - pi * pi, ni = 2.f * pr * pi; pr = nr; pi = ni; }
        hr = 0.f; hi_ = 0.f;
        for (int s = 0; s < seg; ++s) { const float er = ex[(((wid & 4) + s) * 64 + lane) * 2], ei = ex[(((wid & 4) + s) * 64 + lane) * 2 + 1];
            const float nr = pr * hr - pi * hi_ + er, ni = pr * hi_ + pi * hr + ei; hr = nr; hi_ = ni; }
        s5_chunks<true>(buf, Ug, Gg, bfrag, cfrag, da, db, ar, ai, hr, hi_, lane, r32, hi);
        __syncthreads();
    }
}

__device__ __forceinline__ void flog_phase(LAS unsigned char* lds, const bf16_t* h, const float* ssq, const bf16_t* WFb, const float* fbias, float* flog, int r0, int r1, int rstride) {
    const int tid = ltid(), lane = tid & 63, wid = __builtin_amdgcn_readfirstlane(tid >> 6), r32 = lane & 31, hi = lane >> 5;
    LAS float* part = (LAS float*)lds;
    for (int rb = r0; rb < r1; rb += rstride) {
        const bf16_t* ap = h + (size_t)(rb * 32 + r32) * DM + wid * 256 + hi * 8;
        const bf16_t* bp = WFb + (size_t)r32 * DM + wid * 256 + hi * 8;
        bf16x8 a[16], b[16];
#pragma unroll
        for (int i = 0; i < 16; ++i) { a[i] = *(const bf16x8*)(ap + i * 16); b[i] = *(const bf16x8*)(bp + i * 16); }
        f32x16 d = {};
#pragma unroll
        for (int i = 0; i < 16; ++i) d = __builtin_amdgcn_mfma_f32_32x32x16_bf16(a[i], b[i], d, 0, 0, 0);
#pragma unroll
        for (int r = 0; r < 16; ++r) part[(wid * 32 + crow(r, hi)) * 33 + r32] = d[r];
        __syncthreads();
        { const int row = tid >> 4, hh = tid & 15; float v = 0.f;
#pragma unroll
          for (int w = 0; w < 8; ++w) v += part[(w * 32 + row) * 33 + hh];
          const int grow = rb * 32 + row;
          const f32x4 q0 = *(const f32x4*)(ssq + (size_t)grow * 8), q1 = *(const f32x4*)(ssq + (size_t)grow * 8 + 4);
          const float f = v * rsqrtf((((q0[0] + q0[1]) + (q0[2] + q0[3])) + ((q1[0] + q1[1]) + (q1[2] + q1[3]))) * (1.0f / 2048.0f) + 1e-6f) + fbias[hh];
          flog[(size_t)grow * 16 + hh] = fminf(f, 0.f) - __logf(1.f + __expf(-fabsf(f))); }
        __syncthreads();
    }
}
__device__ __forceinline__ void cs_qknorm_phase(LAS unsigned char* lds, const float* flog, float* cs, bf16_t* Q, bf16_t* K, const float* qw, const float* kw, int half, int vb, int vg) {
    const int tid = ltid(), lane = tid & 63, wid = __builtin_amdgcn_readfirstlane(tid >> 6);
    f32_ma* red = (f32_ma*)lds;
    for (int seq = 32 * half + vb; seq < 32 * half + 32; seq += vg) {
        const int b = seq >> 4, hh = seq & 15; float v[4];
#pragma unroll
        for (int i = 0; i < 4; ++i) v[i] = flog[((size_t)b * SEQ + 4 * tid + i) * 16 + hh];
        v[1] += v[0]; v[2] += v[1]; v[3] += v[2];
        float inc = v[3];
#pragma unroll
        for (int o = 1; o < 64; o <<= 1) { const float n = __shfl_up(inc, o); if (lane >= o) inc += n; }
        if (lane == 63) red[wid] = inc;
        __syncthreads();
        float base = 0.f;
        for (int w = 0; w < wid; ++w) base += red[w];
        const float ex = base + inc - v[3], inv = 11.313708498984761f;
        *(f32x4*)(cs + (size_t)seq * SEQ + 4 * tid) = (f32x4){(ex + v[0]) * inv, (ex + v[1]) * inv, (ex + v[2]) * inv, (ex + v[3]) * inv};
        __syncthreads();
    }
    const int gw = vb * 8 + wid, NGW = vg * 8, sub = lane >> 4, l16 = lane & 15;
    const f32x4 wq0 = *(const f32x4*)(qw + l16 * 8), wq1 = *(const f32x4*)(qw + l16 * 8 + 4), wk0 = *(const f32x4*)(kw + l16 * 8), wk1 = *(const f32x4*)(kw + l16 * 8 + 4);
    for (int it0 = gw; it0 < 32768; it0 += 4 * NGW) {
        u32x4 raw[4]; bf16_t* pp[4]; bool kk[4];
#pragma unroll
        for (int q = 0; q < 4; ++q) { const int it = it0 + q * NGW; kk[q] = it >= 16384; pp[q] = (kk[q] ? K : Q) + ((size_t)((16384 * half + (it & 16383)) * 4 + sub)) * 128 + l16 * 8; raw[q] = (it < 32768) ? *(const u32x4*)pp[q] : (u32x4){0u, 0u, 0u, 0u}; }
#pragma unroll
        for (int q = 0; q < 4; ++q) { const int it = it0 + q * NGW;
            f32x4 a, bq; pg8::unpack8f(raw[q], a, bq);
            float ss = (a[0] * a[0] + a[1] * a[1]) + (a[2] * a[2] + a[3] * a[3]) + (bq[0] * bq[0] + bq[1] * bq[1]) + (bq[2] * bq[2] + bq[3] * bq[3]);
            ss += __shfl_xor(ss, 1); ss += __shfl_xor(ss, 2); ss += __shfl_xor(ss, 4); ss += __shfl_xor(ss, 8);
            const float rs = rsqrtf(ss * (1.0f / 128.0f) + 1e-6f);
            a = a * rs * (kk[q] ? wk0 : wq0); bq = bq * rs * (kk[q] ? wk1 : wq1);
            if (it < 32768) *(u32x4*)pp[q] = pg8::pack8f(a, bq); }
    }
}
template <int W>
__device__ __forceinline__ void pool_item(const bf16_t* U, bf16_t* G, int row0, int t0, int col0) {
    u32x4 rows[15 + W];
#pragma unroll
    for (int j = 0; j < 15 + W; ++j) { const int t = t0 - (W - 1) + j; rows[j] = (u32x4){0u, 0u, 0u, 0u}; if (t >= 0) rows[j] = *(const u32x4*)(U + (size_t)(row0 - (W - 1) + j) * DM + col0); }
    f32x4 s0 = {0.f, 0.f, 0.f, 0.f}, s1 = s0;
#pragma unroll
    for (int j = 0; j < W - 1; ++j) { f32x4 a, b; pg8::unpack8f(rows[j], a, b); s0 += a; s1 += b; }
#pragma unroll
    for (int i = 0; i < 16; ++i) { const int t = t0 + i;
        f32x4 a, b; pg8::unpack8f(rows[W - 1 + i], a, b); s0 += a; s1 += b;
        const float ic = 1.0f / (float)((t + 1) < W ? (t + 1) : W);
        *(u32x4*)(G + (size_t)(row0 + i) * DM + col0) = pg8::pack8f(s0 * ic - a, s1 * ic - b);
        f32x4 c, d; pg8::unpack8f(rows[i], c, d); s0 -= c; s1 -= d; }
}
__device__ __forceinline__ void pool_phase(const bf16_t* U, bf16_t* G, int i0, int i1, int istride) {
    for (int item = i0 + ltid(); item < i1; item += istride) {
        const int rb = item >> 8, ch = item & 255, col0 = ch * 8, grp = col0 >> 9, row0 = rb * 16, t0 = row0 & (SEQ - 1);
        if (grp == 0) pool_item<2>(U, G, row0, t0, col0); else if (grp == 1) pool_item<4>(U, G, row0, t0, col0); else if (grp == 2) pool_item<8>(U, G, row0, t0, col0); else pool_item<16>(U, G, row0, t0, col0);
    }
}
__device__ __forceinline__ att::BlockRef<att::bf16, att::bf16> att_ref(int bh, int qb, const bf16_t* Q, const bf16_t* K, const bf16_t* V, bf16_t* YZ, const bf16_t* SZI, const float* cs) {
    att::BlockRef<att::bf16, att::bf16> r; const int b = bh >> 4, hh = bh & 15;
    r.Q = (const att::bf16*)Q + ((size_t)bh * SEQ + (size_t)qb * 256) * 128; r.K = (const att::bf16*)K + (size_t)bh * SEQ * 128; r.V = (const att::bf16*)V + (size_t)bh * SEQ * 128;
    r.O = (att::bf16*)YZ + ((size_t)b * SEQ + (size_t)qb * 256) * DM + hh * 128; r.OI = (const att::bf16*)SZI + ((size_t)b * SEQ + (size_t)qb * 256) * DM + hh * 128; r.CS = cs + (size_t)bh * SEQ; r.P0 = qb * 256;
    return r;
}
__device__ __forceinline__ void attn_phase(att::lchar* lds, const bf16_t* Q, const bf16_t* K, const bf16_t* V, bf16_t* YZ, const bf16_t* SZI, float* cs, const float* flog, int L0, int total, int stride) {
    int L = L0; if (L >= total) return;
    { const int tid = ltid(), lane = tid & 63, wid = __builtin_amdgcn_readfirstlane(tid >> 6), seq = L >> 2, b = seq >> 4, hh = seq & 15;
      LAS float* red = (LAS float*)lds; float v[4];
#pragma unroll
      for (int i = 0; i < 4; ++i) v[i] = flog[((size_t)b * SEQ + 4 * tid + i) * 16 + hh];
      v[1] += v[0]; v[2] += v[1]; v[3] += v[2];
      float inc = v[3];
#pragma unroll
      for (int o = 1; o < 64; o <<= 1) { const float n = __shfl_up(inc, o); if (lane >= o) inc += n; }
      if (lane == 63) red[wid] = inc;
      __syncthreads();
      float base = 0.f;
      for (int w = 0; w < wid; ++w) base += red[w];
      const float ex = base + inc - v[3], inv = 11.313708498984761f;
      *(f32x4*)(cs + (size_t)seq * SEQ + 4 * tid) = (f32x4){(ex + v[0]) * inv, (ex + v[1]) * inv, (ex + v[2]) * inv, (ex + v[3]) * inv};
      asm volatile("s_waitcnt vmcnt(0)" ::: "memory");
      __syncthreads(); }
    int pass = 0;
    att::BlockRef<att::bf16, att::bf16> cur = att_ref(L >> 2, L & 3, Q, K, V, YZ, SZI, cs);
    att::Seam<att::bf16> S;
    att::causal_swa_prime<att::bf16, att::bf16>(cur, SEQ, lds, S);
    for (;;) {
        const bool more_pass = pass == 0, more_item = L + stride < total, last = !more_pass && !more_item;
        int passn = pass + 1, Ln = L;
        if (!more_pass) { passn = 0; Ln = more_item ? L + stride : L; }
        const int qbn = passn ? 7 - (Ln & 3) : (Ln & 3);
        const att::BlockRef<att::bf16, att::bf16> nxt = last ? cur : att_ref(Ln >> 2, qbn, Q, K, V, YZ, SZI, cs);
        att::causal_swa_block<att::bf16, att::bf16>(cur, nxt, SEQ, SEQ, lds, S);
        if (last) break;
        cur = nxt; pass = passn; L = Ln;
    }
}

#define XB_TMO      128
#define XB_XCNT(j)  (256  + 64 * (j))
#define XB_XSUB(j)  (1280 + 64 * (j))
#define XB_XGEN(j)  (2304 + 64 * (j))
#define XB_TOP      3328
#define XB_TOPGEN   3392
#define XCD_BAR_WORDS 3456
#define XB_SPIN_CAP (1u << 18)

__device__ __forceinline__ unsigned xb_ld(unsigned* p)              { return __hip_atomic_load(p, __ATOMIC_RELAXED, __HIP_MEMORY_SCOPE_AGENT); }
__device__ __forceinline__ unsigned xb_add(unsigned* p, unsigned v) { return __hip_atomic_fetch_add(p, v, __ATOMIC_RELAXED, __HIP_MEMORY_SCOPE_AGENT); }
__device__ __forceinline__ unsigned xb_xcc_id() { return (unsigned)__builtin_amdgcn_s_getreg((3 << 11) | 20) & 0xFu; }
#define XB_SPIN(cond, bar) do { unsigned _sp = 0; while (cond) { __builtin_amdgcn_s_sleep(1); \
    if ((++_sp & 255u) == 0u) { if (xb_ld(&(bar)[XB_TMO])) break; if (_sp > XB_SPIN_CAP) { atomicAdd(&(bar)[XB_TMO], 1u); break; } } } } while (0)

struct XcdBarrier {
    unsigned* bar; unsigned x; unsigned G;
    volatile LAS unsigned* st;
};

__device__ __forceinline__ XcdBarrier xcd_barrier_post(unsigned* bar, volatile LAS unsigned* st) {
    XcdBarrier b; b.bar = bar; b.x = xb_xcc_id(); b.st = st; b.G = 0;
    if (threadIdx.x == 0) (void)xb_add(&bar[XB_XCNT(b.x)], 1u);
    return b;
}
__device__ __forceinline__ void xcd_barrier_complete(unsigned* bar, unsigned x, unsigned& nloc, unsigned& nx, const unsigned G) {
    unsigned sum, cnt, mine, sp = 0u;
    for (;;) {
        sum = 0u; cnt = 0u; mine = 0u;
#pragma unroll
        for (unsigned j = 0; j < 16; ++j) { const unsigned c = xb_ld(&bar[XB_XCNT(j)]); sum += c; cnt += (c > 0u) ? 1u : 0u; mine = (j == x) ? c : mine; }
        if (sum == G) break;
        __builtin_amdgcn_s_sleep(1);
        if ((++sp & 255u) == 0u) { if (xb_ld(&bar[XB_TMO])) break; if (sp > XB_SPIN_CAP) { atomicAdd(&bar[XB_TMO], 1u); break; } }
    }
    nloc = mine > 0u ? mine : 1u; nx = cnt > 0u ? cnt : 1u;
}

__device__ __forceinline__ void xcd_barrier(const XcdBarrier& b) {
    asm volatile("s_waitcnt vmcnt(0)" ::: "memory");
    __syncthreads();
    if (threadIdx.x == 0) {
        unsigned* bar = b.bar;
        __builtin_amdgcn_s_waitcnt(0);
        unsigned nloc = b.st[0], nx = b.st[1];
        if (nloc == 0u) { xcd_barrier_complete(bar, b.x, nloc, nx, b.G); b.st[0] = nloc; b.st[1] = nx; }
        const unsigned old = xb_add(&bar[XB_XSUB(b.x)], 1u);
        const unsigned gen = old / nloc;
        if (old + 1u == (gen + 1u) * nloc) {
            __builtin_amdgcn_fence(__ATOMIC_RELEASE, "agent");
            asm volatile("s_waitcnt vmcnt(0)" ::: "memory");
            const unsigned og = xb_add(&bar[XB_TOP], 1u);
            const unsigned tg = og / nx;
            if (og + 1u == (tg + 1u) * nx) xb_add(&bar[XB_TOPGEN], 1u);
            else XB_SPIN(xb_ld(&bar[XB_TOPGEN]) == tg, bar);
            __builtin_amdgcn_fence(__ATOMIC_ACQUIRE, "agent");
            xb_add(&bar[XB_XGEN(b.x)], 1u);
            asm volatile("s_waitcnt vmcnt(0)" ::: "memory");
        } else {
            XB_SPIN(xb_ld(&bar[XB_XGEN(b.x)]) == gen, bar);
            __builtin_amdgcn_fence(__ATOMIC_ACQUIRE, "agent");
            asm volatile("s_waitcnt vmcnt(0)" ::: "memory");
        }
    }
    __syncthreads();
}

template <class T> __device__ __forceinline__ T* asglobal(T* p) { return (T*)(__attribute__((address_space(1))) T*)p; }
typedef const __attribute__((address_space(4))) Params* KArgs;
#define PIN(i) asglobal(Pk->in[i])
#define WSP(T, off) ((T*)(ws + (off)))
__global__ void __launch_bounds__(512, 2) mega(Params P) {
    extern __shared__ __attribute__((aligned(16))) unsigned char lds[];
    cg::grid_group grid = cg::this_grid();
    volatile LAS unsigned* bst = (volatile LAS unsigned*)((LAS unsigned char*)lds + LDS_BYTES - 64);
    if (threadIdx.x < 4) bst[threadIdx.x] = 0u;
    __syncthreads();
    const int half = lbid() >> 7, vb = lbid() & 127, vg = 128;
    { unsigned* bw = (unsigned*)(P.ws + WS_MISC + MS_BAR); for (int i = blockIdx.x * 512 + threadIdx.x; i < (int)(BAR_BYTES / 4); i += gridDim.x * 512) bw[i] = 0u; }
    grid.sync();
    (void)xcd_barrier_post((unsigned*)(P.ws + WS_MISC + MS_BAR), bst);
    (void)xcd_barrier_post((unsigned*)(P.ws + WS_MISC + MS_BAR) + (1 + (blockIdx.x >> 7)) * XCD_BAR_WORDS, bst + 2);
#define XBAR_G() do { XcdBarrier xb_; xb_.bar = (unsigned*)(asglobal(((KArgs)__builtin_amdgcn_kernarg_segment_ptr())->ws) + WS_MISC + MS_BAR); xb_.x = xb_xcc_id(); xb_.st = bst; xb_.G = 256u; xcd_barrier(xb_); } while (0)
#define XBAR_H() do { XcdBarrier xb_; xb_.bar = (unsigned*)(asglobal(((KArgs)__builtin_amdgcn_kernarg_segment_ptr())->ws) + WS_MISC + MS_BAR) + (1 + half) * XCD_BAR_WORDS; xb_.x = xb_xcc_id(); xb_.st = bst + 2; xb_.G = 128u; xcd_barrier(xb_); } while (0)
    { KArgs Pk = (KArgs)__builtin_amdgcn_kernarg_segment_ptr(); asm volatile("" : "+s"(Pk)); prologue(Pk, (LAS unsigned char*)lds); }
    XBAR_G();
    if (half) { KArgs Pk = (KArgs)__builtin_amdgcn_kernarg_segment_ptr(); asm volatile("" : "+s"(Pk)); convert_rest(Pk, (LAS unsigned char*)lds, 6272, 12544, vb, vg); __syncthreads(); }
    for (int ph = 1; ph < NPHASE; ++ph) {
        KArgs Pk = (KArgs)__builtin_amdgcn_kernarg_segment_ptr(); asm volatile("" : "+s"(Pk));
        unsigned char* ws = asglobal(Pk->ws);
        const int layer = (ph - 1) >> 2, sub = (ph - 1) & 3;
        const int kind = layer % 3, j = layer / 3;
        if (sub == 1) {
            if (kind == 0) s5_phase((LAS unsigned char*)lds, WSP(bf16_t, WS_U), WSP(bf16_t, WS_K), WSP(float, WS_MISC + MS_ABAR) + (size_t)j * 128 * 64 * 2, WSP(bf16_t, WS_MISC + MS_BBAR) + (size_t)j * 128 * 128 * 16,
                                    WSP(bf16_t, WS_MISC + MS_CM) + (size_t)j * 128 * 16 * 128, PIN(11) + j * DM, 128 * half + vb, 128 * half + 128, vg);
            else if (kind == 1) {   }
            else pool_phase(WSP(bf16_t, WS_U), WSP(bf16_t, WS_K), 65536 * half + vb * 512, 65536 * half + 65536, vg * 512);
        } else if (sub == 2 && kind == 1) {
            attn_phase((att::lchar*)lds, WSP(bf16_t, WS_U), WSP(bf16_t, WS_K), WSP(bf16_t, WS_V), WSP(bf16_t, WS_SZ), WSP(bf16_t, WS_SZ), WSP(float, WS_MISC + MS_CS), WSP(float, WS_MISC + MS_FLOG), 128 * half + vb, 128 * half + 128, vg);
        } else {
            const bf16_t* gA; const bf16_t* gB; int gN = DM, gK = DM, ggrp = 0, emode;
            const float* e_ssq = nullptr; const bf16_t* e_g = nullptr; const float* e_vec = nullptr; const float* e_hin = nullptr; bf16_t* e_hb = nullptr; float* e_ssqo = nullptr; float* e_hout = nullptr;
            float* ssq = WSP(float, WS_MISC + MS_SSQ);
            if (sub == 0) {
                gA = WSP(bf16_t, WS_HB); e_ssq = ssq + (size_t)layer * MTOK * 8;
                if (kind == 0) { gB = WSP(bf16_t, WS_W_S5IN) + (size_t)j * 4096 * 2048; gN = 4096; emode = pg8::EM_UZ; }
                else if (kind == 1) { gB = WSP(bf16_t, WS_W_FOXIN); gN = 8192; emode = pg8::EM_QKVZ; }
                else { gB = WSP(bf16_t, WS_W_POOLIN); gN = 4096; emode = pg8::EM_UZ; }
            } else if (sub == 2) {
                gA = WSP(bf16_t, WS_K); e_g = gA;
                if (kind == 0) { gB = WSP(bf16_t, WS_W_GLU) + (size_t)j * 2048 * 2048; emode = pg8::EM_GLU; e_vec = PIN(13) + j * DM; }
                else { gB = WSP(bf16_t, WS_W_POOLG); gK = 512; ggrp = 2; emode = pg8::EM_POOL; e_vec = PIN(20); }
            } else {
                gA = WSP(bf16_t, WS_SZ); gB = WSP(bf16_t, WS_W_OUT) + (size_t)layer * 2048 * 2048; emode = pg8::EM_OUT;
                e_hin = layer == 0 ? PIN(0) : (const float*)asglobal(Pk->out); e_hout = asglobal(Pk->out);
                e_hb = layer < 3 ? WSP(bf16_t, WS_HB) : nullptr; e_ssqo = layer < 3 ? ssq + (size_t)(layer + 1) * MTOK * 8 : nullptr;
            }
            { const pg8::Gemm g{gA, gB, MTOK / 2, gN, gK, DM, ggrp};
              const pg8::Epi E{(PG8_LAS float*)((PG8_LAS unsigned char*)lds + 131072), PIN(15), PIN(16), emode, (emode == pg8::EM_OUT || (DRAIN_ALL && emode >= pg8::EM_GLU)) ? 1 : 0, e_ssq, WSP(bf16_t, WS_U), WSP(bf16_t, WS_SZ), WSP(bf16_t, WS_SZ), e_g, e_vec, e_hin, nullptr, nullptr, e_hout, e_hb, nullptr, e_ssqo};
              pg8::StaticOrder S; S.init(MTOK / 2, gN, vg, vb, 16 * half);
              pg8::gemm_phase<pg8::Epi, pg8::StaticOrder, true, true>((PG8_LAS unsigned char*)lds, g, S, E); }
            if (sub == 0 && kind == 1) { __syncthreads();
                flog_phase((LAS unsigned char*)lds, WSP(bf16_t, WS_HB), ssq + (size_t)layer * MTOK * 8, WSP(bf16_t, WS_MISC + MS_WF), PIN(17), WSP(float, WS_MISC + MS_FLOG), 128 * half + vb, 128 * half + 128, vg); }
        }
        if (ph == 4) { if (!half) { convert_rest(Pk, (LAS unsigned char*)lds, 0, 6272, vb, vg); } XBAR_G(); }
        else if (ph + 1 < NPHASE && !(sub == 1 && kind == 1)) XBAR_H();
    }
}
}

extern "C" void kernel_launch(void* const* d_in, const int* in_sizes, int n_in, void* d_out, int out_size, void* d_ws, size_t ws_size, hipStream_t stream) {
    static int grid = 0;
    if (grid == 0) {
        if (n_in != 21 || out_size != mk::MTOK * mk::DM || ws_size < mk::WS_END) { fprintf(stderr, "kernel_launch: unexpected problem (n_in %d, out %d, ws %zu < %zu)\n", n_in, out_size, ws_size, (size_t)mk::WS_END); grid = -1; return; }
        int dev = 0, cus = 0, per_cu = 0;
        if (hipGetDevice(&dev) != hipSuccess || hipDeviceGetAttribute(&cus, hipDeviceAttributeMultiprocessorCount, dev) != hipSuccess) { grid = -1; return; }
        if (hipFuncSetAttribute((const void*)mk::mega, hipFuncAttributeMaxDynamicSharedMemorySize, mk::LDS_BYTES) != hipSuccess) { fprintf(stderr, "kernel_launch: hipFuncSetAttribute failed\n"); grid = -1; return; }
        if (hipOccupancyMaxActiveBlocksPerMultiprocessor(&per_cu, (const void*)mk::mega, 512, mk::LDS_BYTES) != hipSuccess || per_cu < 1) { fprintf(stderr, "kernel_launch: occupancy query says %d blocks per CU\n", per_cu); grid = -1; return; }
        grid = cus * per_cu;
        if (grid != 256) { fprintf(stderr, "kernel_launch: this build splits the grid into two halves of 128 workgroups and needs exactly 256 (got %d)\n", grid); grid = -1; return; }
    }
    if (grid < 0) return;
    mk::Params p{};
    for (int i = 0; i < 21; ++i) p.in[i] = (const float*)d_in[i];
    p.out = (float*)d_out; p.ws = (unsigned char*)d_ws;
    p.ph_lo = 0; p.ph_hi = mk::NPHASE; void* args[] = {&p};
    hipError_t e = hipLaunchCooperativeKernel((const void*)mk::mega, dim3(grid), dim3(512), args, mk::LDS_BYTES, stream);
    if (e != hipSuccess) fprintf(stderr, "kernel_launch: cooperative launch failed: %s (grid %d)\n", hipGetErrorString(e), grid);
}
```

```cpp
#include <hip/hip_runtime.h>
#include <hip/hip_cooperative_groups.h>
#include <hip/hip_bf16.h>
#include <cstdio>
#include <cstdint>
namespace cg = cooperative_groups;
#ifndef PROBE_PH
#define PROBE_PH (-1)
#endif
#ifndef PROBE_NOEPI
#define PROBE_NOEPI 0
#endif
#ifndef PROBE_SYNC
#define PROBE_SYNC 0
#endif
#ifndef PROBE_NOFLOG
#define PROBE_NOFLOG 0
#endif
#ifndef RESID_MODE
#define RESID_MODE 0
#endif
#ifndef HALF_DELAY_TICKS
#define HALF_DELAY_TICKS 0
#endif
#ifndef DRAIN_ALL
#define DRAIN_ALL 1
#endif
#ifndef MK_MULTI
#define MK_MULTI 0
#endif
__device__ __forceinline__ int ltid() { int t = threadIdx.x; asm volatile("" : "+v"(t)); return t; }
__device__ __forceinline__ int lgrid() { int g = gridDim.x; asm volatile("" : "+s"(g)); return g; }
__device__ __forceinline__ int lbid() { int b = blockIdx.x; asm volatile("" : "+s"(b)); return b; }
namespace pg8 {
#define PG8_LAS __attribute__((address_space(3)))
typedef unsigned short bf16_t;
typedef short bf16x8 __attribute__((ext_vector_type(8)));
typedef float f32x4 __attribute__((ext_vector_type(4)));
typedef unsigned u32x4 __attribute__((ext_vector_type(4)));
constexpr int BM = 256, BK = 64, HALF = 128, HTB = HALF * BK * 2  , STAGE_BYTES = 8 * HTB, NXCD = 8, WGM = 8;

__host__ __device__ __forceinline__ int lds_byte(int r, int c) { const int st = (r >> 4) * 2 + (c >> 5), rr = r & 15, cc = c & 31, ob = rr * 64 + cc * 2; return st * 1024 + (ob ^ (((ob >> 9) & 1) << 5)); }
__host__ __device__ __forceinline__ void stage_rc(int b, int& R, int& C) { const int st = b / 1024, sb = b % 1024, swz = sb ^ (((sb >> 9) & 1) << 5); R = (st >> 1) * 16 + swz / 64; C = (st & 1) * 32 + (swz % 64) / 2; }
__host__ __device__ __forceinline__ int perm32(int rho) { const int n = rho >> 4, i = rho & 15; return 8 * (i >> 2) + 4 * n + (i & 3); }

struct Unit { int pm, pn; };
struct Gemm { const bf16_t* A; const bf16_t* Bt; int M, N, K, lda, grp; };

struct StaticOrder {
    int nM, nN, nwg, G, c, pmo, nx;
    __host__ __device__ void init(int M, int N, int G_, int c_, int pmo_ = 0, int nx_ = NXCD) { nM = M / BM; nN = N / BM; nwg = nM * nN; G = G_; c = c_; pmo = pmo_; nx = nx_; }
    __host__ __device__ bool next(int i, Unit& u) const {
        const long L = (long)i * G + c; if (L >= nwg) return false;
        int wgid = (int)L; { const int q = nwg / nx, r = nwg % nx, xcd = wgid % nx, off = wgid / nx; wgid = (xcd < r ? xcd * (q + 1) : r * (q + 1) + (xcd - r) * q) + off; }
        const int nig = WGM * nN, gid = wgid / nig, fm = gid * WGM, gsz = (nM - fm) < WGM ? (nM - fm) : WGM;
        u.pm = fm + ((wgid % nig) % gsz) + pmo; u.pn = (wgid % nig) / gsz; return true;
    }
    __device__ __forceinline__ void a_ready(const Unit&) const {}
    __device__ __forceinline__ void done(const Unit&) const {}
};

__device__ __forceinline__ unsigned cvt_pk_bf16(float lo, float hi) { unsigned r; asm volatile("v_cvt_pk_bf16_f32 %0, %1, %2" : "=v"(r) : "v"(lo), "v"(hi)); return r; }
typedef float f32x2 __attribute__((ext_vector_type(2)));
typedef unsigned u32x2 __attribute__((ext_vector_type(2)));
#ifndef EPI_RB
#define EPI_RB 8
#endif
#ifndef EPI_PREFETCH
#define EPI_PREFETCH 0
#endif
#ifndef EPI_NT
#define EPI_NT 0
#endif
#if EPI_NT
#define NTST(p, v) __builtin_nontemporal_store((v), (p))
#else
#define NTST(p, v) (*(p) = (v))
#endif
#ifndef EPI_WT
#define EPI_WT 1
#endif
#if 1
#endif
__device__ __forceinline__ float bf_lo(unsigned w) { return __uint_as_float(w << 16); }
__device__ __forceinline__ float bf_hi(unsigned w) { return __uint_as_float(w & 0xffff0000u); }
__device__ __forceinline__ float sigm_f(float v) { return __builtin_amdgcn_rcpf(1.f + __expf(-v)); }
__device__ __forceinline__ float silu_f(float v) { return v * sigm_f(v); }
__device__ __forceinline__ u32x4 pack8f(f32x4 a, f32x4 b) { u32x4 w; w.x = cvt_pk_bf16(a[0], a[1]); w.y = cvt_pk_bf16(a[2], a[3]); w.z = cvt_pk_bf16(b[0], b[1]); w.w = cvt_pk_bf16(b[2], b[3]); return w; }
__device__ __forceinline__ void unpack8f(u32x4 w, f32x4& a, f32x4& b) { a = (f32x4){bf_lo(w.x), bf_hi(w.x), bf_lo(w.y), bf_hi(w.y)}; b = (f32x4){bf_lo(w.z), bf_hi(w.z), bf_lo(w.w), bf_hi(w.w)}; }

enum { EM_UZ = 0, EM_QKVZ = 1, EM_GLU = 2, EM_POOL = 3, EM_OUT = 4 };
struct Epi {
    static constexpr bool PERM = true, AFTER_DRAIN = false;
    PG8_LAS float* xl; const float* qw; const float* kw;
    int mode; int drain;
    const float* ssq;
    bf16_t *o0, *o3;
    static constexpr size_t OSTR = (size_t)16 << 20;
    bf16_t* o3w;
    const bf16_t* gsrc;
    const float* vec;
    const float* hin; const bf16_t* hbin; const bf16_t* hlin; float* hout; bf16_t* hb; bf16_t* hl; float* ssq_out;
    __device__ __forceinline__ void operator()(const f32x4 (&acc)[2][2][4][2], const Unit& u, int wr, int wc, int fr, int fq) const {
        const int row0 = u.pm * BM + wr * 64 + fr;
        const int cw = wc * 32 + 8 * fq;
        if (mode == EM_UZ || mode == EM_QKVZ) {
            const int region = u.pn >> 3, ct = (u.pn & 7) * BM;
            const bool zreg = (mode == EM_UZ) ? (region == 1) : (region == 3);
            bf16_t* base = o0 + (size_t)(zreg ? 3 : region) * OSTR;
            const __amdgpu_buffer_rsrc_t wrs = __builtin_amdgcn_make_buffer_rsrc((void*)o0, (short)0, (int)(4 * OSTR * 2), 0x00020000);
            const unsigned wbase = (unsigned)((zreg ? 3 : region) * (OSTR * 2));
            const bool headmajor = (mode == EM_QKVZ) && !zreg;
            if (mode == EM_QKVZ && region < 2) {
                float rsv[2][4];
#pragma unroll
                for (int ai = 0; ai < 2; ++ai)
#pragma unroll
                    for (int m = 0; m < 4; ++m) {
                        const int row = row0 + ai * HALF + m * 16, rl = ai * HALF + wr * 64 + m * 16 + fr;
                        const f32x4 q0 = *(const f32x4*)(ssq + (size_t)row * 8), q1 = *(const f32x4*)(ssq + (size_t)row * 8 + 4);
                        const float rs = rsqrtf((((q0[0] + q0[1]) + (q0[2] + q0[3])) + ((q1[0] + q1[1]) + (q1[2] + q1[3]))) * (1.0f / 2048.0f) + 1e-6f);
                        rsv[ai][m] = rs;
#pragma unroll
                        for (int bj = 0; bj < 2; ++bj) { const f32x4 v0 = acc[ai][bj][m][0] * rs, v1 = acc[ai][bj][m][1] * rs;
                            float s = (v0[0] * v0[0] + v0[1] * v0[1]) + (v0[2] * v0[2] + v0[3] * v0[3]) + (v1[0] * v1[0] + v1[1] * v1[1]) + (v1[2] * v1[2] + v1[3] * v1[3]);
                            s += __shfl_xor(s, 16); s += __shfl_xor(s, 32);
                            if (fq == 0) xl[(rl * 2 + bj) * 4 + wc] = s; }
                    }
                asm volatile("s_waitcnt lgkmcnt(0)\n\ts_barrier" ::: "memory");
                const float* nw = qw + cw; const float* nk = kw + cw;
                f32x4 w0 = *(const f32x4*)nw, w1 = *(const f32x4*)(nw + 4); const f32x4 k0 = *(const f32x4*)nk, k1 = *(const f32x4*)(nk + 4);
                if (region == 1) { w0 = k0; w1 = k1; }
#pragma unroll
                for (int ai = 0; ai < 2; ++ai)
#pragma unroll
                    for (int m = 0; m < 4; ++m) {
                        const int row = row0 + ai * HALF + m * 16, rl = ai * HALF + wr * 64 + m * 16 + fr, b = row >> 11, tt = row & 2047;
#pragma unroll
                        for (int bj = 0; bj < 2; ++bj) { const f32x4 pp = *(const PG8_LAS f32x4*)(xl + (rl * 2 + bj) * 4);
                            const float rh = rsqrtf(((pp[0] + pp[1]) + (pp[2] + pp[3])) * (1.0f / 128.0f) + 1e-6f) * rsv[ai][m];
                            const f32x4 v0 = acc[ai][bj][m][0] * rh * w0, v1 = acc[ai][bj][m][1] * rh * w1;
                            const int head = (ct >> 7) + bj; const size_t off = ((size_t)((b * 16 + head) * 2048 + tt)) * 128 + cw;
                            *(u32x4*)(base + off) = pack8f(v0, v1); }
                    }
            } else
#pragma unroll
            for (int ai = 0; ai < 2; ++ai)
#pragma unroll
                for (int m = 0; m < 4; ++m) {
                    const int row = row0 + ai * HALF + m * 16;
                    const f32x4 q0 = *(const f32x4*)(ssq + (size_t)row * 8), q1 = *(const f32x4*)(ssq + (size_t)row * 8 + 4);
                    const float rs = rsqrtf((((q0[0] + q0[1]) + (q0[2] + q0[3])) + ((q1[0] + q1[1]) + (q1[2] + q1[3]))) * (1.0f / 2048.0f) + 1e-6f);
#pragma unroll
                    for (int bj = 0; bj < 2; ++bj) {
                        f32x4 v0 = acc[ai][bj][m][0] * rs, v1 = acc[ai][bj][m][1] * rs;
                        if (zreg) {
#pragma unroll
                            for (int e = 0; e < 4; ++e) { v0[e] = silu_f(v0[e]); v1[e] = silu_f(v1[e]); }
                        }
                        size_t off;
                        if (headmajor) { const int head = (ct >> 7) + bj, b = row >> 11, t = row & 2047; off = ((size_t)((b * 16 + head) * 2048 + t)) * 128 + cw; }
                        else off = (size_t)row * 2048 + ct + bj * HALF + cw;
                        if (EPI_WT == 2) __builtin_amdgcn_raw_buffer_store_b128(pack8f(v0, v1), wrs, wbase + (unsigned)(off * 2), 0, 16);
                        else NTST((u32x4*)(base + off), pack8f(v0, v1));
                    }
                }
        } else if (mode == EM_GLU || mode == EM_POOL) {
            const int col0 = u.pn * BM + cw;
            f32x4 bv[2][2];
#pragma unroll
            for (int bj = 0; bj < 2; ++bj) { bv[bj][0] = *(const f32x4*)(vec + col0 + bj * HALF); bv[bj][1] = *(const f32x4*)(vec + col0 + bj * HALF + 4); }
#pragma unroll
            for (int ai = 0; ai < 2; ++ai) {
                u32x4 sr[4][2], gr[4][2];
#pragma unroll
                for (int m = 0; m < 4; ++m)
#pragma unroll
                    for (int bj = 0; bj < 2; ++bj) { const size_t off = (size_t)(row0 + ai * HALF + m * 16) * 2048 + col0 + bj * HALF;
                        sr[m][bj] = *(const u32x4*)(o3 + off); if (mode == EM_GLU) gr[m][bj] = *(const u32x4*)(gsrc + off); else gr[m][bj] = (u32x4){0u, 0u, 0u, 0u}; }
#pragma unroll
                for (int m = 0; m < 4; ++m)
#pragma unroll
                    for (int bj = 0; bj < 2; ++bj) { const size_t off = (size_t)(row0 + ai * HALF + m * 16) * 2048 + col0 + bj * HALF;
                        f32x4 s0, s1; unpack8f(sr[m][bj], s0, s1);
                        f32x4 v0 = acc[ai][bj][m][0], v1 = acc[ai][bj][m][1];
                        if (mode == EM_GLU) { f32x4 g0, g1; unpack8f(gr[m][bj], g0, g1);
#pragma unroll
                            for (int e = 0; e < 4; ++e) { v0[e] = g0[e] * sigm_f(v0[e] + bv[bj][0][e]); v1[e] = g1[e] * sigm_f(v1[e] + bv[bj][1][e]); }
                        } else { v0 = v0 * bv[bj][0]; v1 = v1 * bv[bj][1]; }
                        *(u32x4*)(o3w + off) = pack8f(v0 * s0, v1 * s1); }
                asm volatile("" ::: "memory");
            }
        }
    }
    __device__ __forceinline__ void prefetch(const Unit& u, PG8_LAS unsigned char* lds, int wid, int lane) const {
        if (!EPI_PREFETCH || mode < EM_GLU) return;
        PG8_LAS unsigned* dump = (PG8_LAS unsigned*)(lds + 135168 + wid * 256);
        if (mode == EM_OUT) {
#pragma unroll
            for (int k = 0; k < 4; ++k) { const int li = wid * 256 + k * 64 + lane, r = li >> 3, l = li & 7;
                __builtin_amdgcn_global_load_lds((const unsigned*)(hin + (size_t)(u.pm * BM + r) * 2048 + u.pn * BM + l * 32), dump, 4, 0, 0); }
        } else {
#pragma unroll
            for (int k = 0; k < 2; ++k) { const int li = wid * 128 + k * 64 + lane, r = li >> 2, l = li & 3; const size_t off = (size_t)(u.pm * BM + r) * 2048 + u.pn * BM + l * 64;
                __builtin_amdgcn_global_load_lds((const unsigned*)(o3 + off), dump, 4, 0, 0);
                if (mode == EM_GLU) __builtin_amdgcn_global_load_lds((const unsigned*)(gsrc + off), dump, 4, 0, 0); }
        }
    }
    template <int ai>
    __device__ __forceinline__ void fused_half(const f32x4 (&acc)[2][2][4][2], const Unit& u, int wr, int wc, int fr, int fq, PG8_LAS float* T, int wid, int lane, const f32x4 bv) const {
        constexpr int LDW = 260, RB = EPI_RB;
        const int colw = wc * 32 + 8 * fq, rl0 = wr * 64 + fr, gcol = u.pn * BM + lane * 4;
        const size_t goff = (size_t)(u.pm * BM + ai * HALF + wid) * 2048 + gcol;
#pragma unroll
        for (int m = 0; m < 4; ++m)
#pragma unroll
            for (int bj = 0; bj < 2; ++bj) { PG8_LAS float* d = T + (rl0 + m * 16) * LDW + bj * HALF + colw; *(PG8_LAS f32x4*)d = acc[ai][bj][m][0]; *(PG8_LAS f32x4*)(d + 4) = acc[ai][bj][m][1]; }
        __syncthreads();
        for (int blk = 0; blk < 16 / RB; ++blk) {
            const size_t bo = goff + (size_t)blk * (8 * RB) * 2048;
            const PG8_LAS float* Tb = T + (wid + 8 * RB * blk) * LDW + lane * 4;
            if (mode == EM_OUT) {
                f32x4 hv[RB];
#pragma unroll
                for (int i = 0; i < RB; ++i) { if (hin) hv[i] = *(const f32x4*)(hin + bo + (size_t)i * 8 * 2048); else { const u32x2 r = *(const u32x2*)(hbin + bo + (size_t)i * 8 * 2048); hv[i] = (f32x4){bf_lo(r.x), bf_hi(r.x), bf_lo(r.y), bf_hi(r.y)};
                        if (hlin) { const u32x2 q = *(const u32x2*)(hlin + bo + (size_t)i * 8 * 2048); hv[i] = hv[i] + (f32x4){bf_lo(q.x), bf_hi(q.x), bf_lo(q.y), bf_hi(q.y)}; } } }
#pragma unroll
                for (int i = 0; i < RB; ++i) {
                    const f32x4 v = *(const PG8_LAS f32x4*)(Tb + 8 * i * LDW) + hv[i];
                    const size_t o = bo + (size_t)i * 8 * 2048;
                    if (hout) { if (EPI_WT) __builtin_amdgcn_raw_buffer_store_b128(__builtin_bit_cast(u32x4, v), __builtin_amdgcn_make_buffer_rsrc((void*)hout, (short)0, (int)(8192 * 2048 * 4), 0x00020000), (unsigned)(o * 4), 0, 16); else *(f32x4*)(hout + o) = v; }
                    if (hb) { u32x2 w; w.x = cvt_pk_bf16(v[0], v[1]); w.y = cvt_pk_bf16(v[2], v[3]); *(u32x2*)(hb + o) = w;
                        if (hl) { const f32x4 r = v - (f32x4){bf_lo(w.x), bf_hi(w.x), bf_lo(w.y), bf_hi(w.y)}; u32x2 wl; wl.x = cvt_pk_bf16(r[0], r[1]); wl.y = cvt_pk_bf16(r[2], r[3]); *(u32x2*)(hl + o) = wl; } }
                    if (ssq_out) { float s = (v[0] * v[0] + v[1] * v[1]) + (v[2] * v[2] + v[3] * v[3]);
#pragma unroll
                        for (int q = 1; q < 32; q <<= 1) s += __shfl_xor(s, q);
                        { auto rr = __builtin_amdgcn_permlane32_swap(__float_as_uint(s), __float_as_uint(s), false, false); s = __uint_as_float(rr[0]) + __uint_as_float(rr[1]); }
                        if (lane == 0) ssq_out[(size_t)(u.pm * BM + ai * HALF + wid + 8 * RB * blk + 8 * i) * 8 + u.pn] = s; }
                }
            } else {
                u32x2 sv[RB], gv[RB];
#pragma unroll
                for (int i = 0; i < RB; ++i) { sv[i] = *(const u32x2*)(o3 + bo + (size_t)i * 8 * 2048); gv[i] = (mode == EM_GLU) ? *(const u32x2*)(gsrc + bo + (size_t)i * 8 * 2048) : (u32x2){0u, 0u}; }
#pragma unroll
                for (int i = 0; i < RB; ++i) {
                    f32x4 v = *(const PG8_LAS f32x4*)(Tb + 8 * i * LDW);
                    const f32x4 s4 = {bf_lo(sv[i].x), bf_hi(sv[i].x), bf_lo(sv[i].y), bf_hi(sv[i].y)};
                    if (mode == EM_GLU) { const f32x4 g4 = {bf_lo(gv[i].x), bf_hi(gv[i].x), bf_lo(gv[i].y), bf_hi(gv[i].y)};
#pragma unroll
                        for (int q = 0; q < 4; ++q) v[q] = g4[q] * sigm_f(v[q] + bv[q]);
                    } else v = v * bv;
                    v = v * s4;
                    u32x2 w; w.x = cvt_pk_bf16(v[0], v[1]); w.y = cvt_pk_bf16(v[2], v[3]); *(u32x2*)(o3w + bo + (size_t)i * 8 * 2048) = w;
                }
            }
        }
        __syncthreads();
    }
    __device__ __forceinline__ void fused(const f32x4 (&acc)[2][2][4][2], const Unit& u, int wr, int wc, int fr, int fq, PG8_LAS unsigned char* lds, int wid, int lane) const {
        f32x4 bv = {0.f, 0.f, 0.f, 0.f};
        if (mode != EM_OUT) bv = *(const f32x4*)(vec + u.pn * BM + lane * 4);
        fused_half<0>(acc, u, wr, wc, fr, fq, (PG8_LAS float*)lds, wid, lane, bv);
        fused_half<1>(acc, u, wr, wc, fr, fq, (PG8_LAS float*)lds, wid, lane, bv);
    }
};
template <class Epi, class Sched, bool ALIGN_EPI = false, bool SP2 = false>
__device__ __forceinline__ void gemm_phase(PG8_LAS unsigned char* lds, const Gemm g, const Sched S, const Epi E) {
    const int tid = ltid(), wid = __builtin_amdgcn_readfirstlane(tid >> 6), lane = tid & 63, wr = wid >> 2, wc = wid & 3, fr = lane & 15, fq = lane >> 4;
    const int K = g.K, nt = K / BK;
    unsigned voffA[2], voffB[2];
#pragma unroll
    for (int i = 0; i < 2; ++i) { int R, C; stage_rc(tid * 16 + i * 8192, R, C); const int Rb = Epi::PERM ? ((R & ~31) + perm32(R & 31)) : R;
        voffA[i] = (unsigned)(R * g.lda + C) * 2u; voffB[i] = (unsigned)(Rb * K + C) * 2u; }
    const size_t kstep = (size_t)(BK * 2);
    const size_t hstepA = (size_t)HALF * g.lda * 2, hstepB = (size_t)HALF * K * 2;
    const size_t tstepA = 2 * hstepA, tstepB = 2 * hstepB;
#define PG8_GOFF(pn_) (g.grp ? (size_t)((pn_) / g.grp) * (size_t)K * 2 : (size_t)0)
    const unsigned ldsw = (unsigned)wid * 1024u;
    const int aoff = lds_byte(wr * 64 + fr, fq * 8), boff = lds_byte(wc * 32 + fr, fq * 8);
#define PG8_SA(b, h) (((b) * 2 + (h)) * HTB)
#define PG8_SB(b, h) ((4 + (b) * 2 + (h)) * HTB)
#define PG8_STAGE(bufoff, gbase, voff) do { _Pragma("unroll") for (int _i = 0; _i < 2; ++_i) \
        __builtin_amdgcn_global_load_lds((const unsigned*)((const char*)(gbase) + (voff)[_i]), (PG8_LAS unsigned*)(lds + (bufoff) + ldsw + _i * 8192), 16, 0, 0); } while (0)
#define PG8_LDA(dst, b, h) do { _Pragma("unroll") for (int m = 0; m < 4; ++m) _Pragma("unroll") for (int k = 0; k < 2; ++k) dst[m][k] = *(const PG8_LAS bf16x8*)(lds + PG8_SA(b, h) + aoff + m * 2048 + k * 1024); } while (0)
#define PG8_LDB(dst, b, h) do { _Pragma("unroll") for (int n = 0; n < 2; ++n) _Pragma("unroll") for (int k = 0; k < 2; ++k) dst[n][k] = *(const PG8_LAS bf16x8*)(lds + PG8_SB(b, h) + boff + n * 2048 + k * 1024); } while (0)
#define PG8_MMA(ai, bj, At, Bt) do { __builtin_amdgcn_s_setprio(1); _Pragma("unroll") for (int m = 0; m < 4; ++m) _Pragma("unroll") for (int n = 0; n < 2; ++n) _Pragma("unroll") for (int k = 0; k < 2; ++k) \
        acc[ai][bj][m][n] = __builtin_amdgcn_mfma_f32_16x16x32_bf16(Bt[n][k], At[m][k], acc[ai][bj][m][n], 0, 0, 0); __builtin_amdgcn_s_setprio(0); } while (0)
#define PG8_WAIT_V(n) asm volatile("s_waitcnt vmcnt(" #n ")" ::: "memory")
#define PG8_WAIT_L(n) asm volatile("s_waitcnt lgkmcnt(" #n ")" ::: "memory")
#define PG8_BAR __builtin_amdgcn_s_barrier()
#define PG8_SCHED __builtin_amdgcn_sched_barrier(0)
    Unit cur, nxt; int ui = 0;
    if (!S.next(0, cur)) return;
    f32x4 acc[2][2][4][2];
#pragma unroll
    for (int a = 0; a < 2; ++a)
#pragma unroll
        for (int b = 0; b < 2; ++b)
#pragma unroll
            for (int m = 0; m < 4; ++m)
#pragma unroll
                for (int n = 0; n < 2; ++n) acc[a][b][m][n] = (f32x4){0.f, 0.f, 0.f, 0.f};
    bf16x8 At[4][2], B0[2][2], B1[2][2];
    const char* cA = (const char*)g.A + (size_t)cur.pm * tstepA + PG8_GOFF(cur.pn); const char* cB = (const char*)g.Bt + (size_t)cur.pn * tstepB;
    S.a_ready(cur);
    E.prefetch(cur, lds, wid, lane);
    if constexpr (SP2) {
        PG8_STAGE(PG8_SB(0, 0), cB, voffB); PG8_STAGE(PG8_SB(0, 1), cB + hstepB, voffB); PG8_STAGE(PG8_SA(0, 0), cA, voffA); PG8_STAGE(PG8_SA(0, 1), cA + hstepA, voffA);
        if (wr == 1) PG8_BAR;
        PG8_WAIT_V(2); PG8_BAR;
        PG8_STAGE(PG8_SB(1, 0), cB + kstep, voffB); PG8_STAGE(PG8_SA(1, 0), cA + kstep, voffA); PG8_STAGE(PG8_SB(1, 1), cB + hstepB + kstep, voffB);
        PG8_WAIT_V(6); PG8_BAR;
    } else {
        PG8_STAGE(PG8_SB(0, 0), cB, voffB); PG8_STAGE(PG8_SA(0, 0), cA, voffA); PG8_STAGE(PG8_SB(0, 1), cB + hstepB, voffB); PG8_STAGE(PG8_SA(0, 1), cA + hstepA, voffA);
        if (wr == 1) PG8_BAR;
        PG8_WAIT_V(4); PG8_BAR;
        PG8_STAGE(PG8_SB(1, 0), cB + kstep, voffB); PG8_STAGE(PG8_SA(1, 0), cA + kstep, voffA); PG8_STAGE(PG8_SB(1, 1), cB + hstepB + kstep, voffB);
        PG8_WAIT_V(6); PG8_BAR;
    }
    for (;;) {
        const bool has_next = S.next(ui + 1, nxt);
        const char* nA = has_next ? (const char*)g.A + (size_t)nxt.pm * tstepA + PG8_GOFF(nxt.pn) : cA; const char* nB = has_next ? (const char*)g.Bt + (size_t)nxt.pn * tstepB : cB;
        for (int t = 0; t < nt; t += 2) {
            const bool last = (t == nt - 2);
            const char* a1 = cA + (size_t)(t + 1) * kstep;
            const char* a2 = last ? nA : cA + (size_t)(t + 2) * kstep; const char* b2 = last ? nB : cB + (size_t)(t + 2) * kstep;
            const char* a3 = a2 + kstep; const char* b3 = b2 + kstep;
            if (last && has_next) S.a_ready(nxt);
            if constexpr (SP2) {
            PG8_LDB(B0, 0, 0); PG8_LDB(B1, 0, 1); PG8_SCHED; PG8_LDA(At, 0, 0); PG8_STAGE(PG8_SA(1, 1), a1 + hstepA, voffA);
            PG8_WAIT_V(8); PG8_WAIT_L(0); PG8_BAR; PG8_MMA(0, 0, At, B0); PG8_MMA(0, 1, At, B1); PG8_BAR; PG8_SCHED;
            PG8_LDA(At, 0, 1); PG8_STAGE(PG8_SB(0, 0), b2, voffB); PG8_STAGE(PG8_SB(0, 1), b2 + hstepB, voffB); PG8_STAGE(PG8_SA(0, 0), a2, voffA);
            PG8_WAIT_V(8); PG8_WAIT_L(0); PG8_BAR; PG8_MMA(1, 0, At, B0); PG8_MMA(1, 1, At, B1); PG8_BAR; PG8_SCHED;
            PG8_LDB(B0, 1, 0); PG8_LDB(B1, 1, 1); PG8_SCHED; PG8_LDA(At, 1, 0); PG8_STAGE(PG8_SA(0, 1), a2 + hstepA, voffA);
            PG8_WAIT_V(8); PG8_WAIT_L(0); PG8_BAR; PG8_MMA(0, 0, At, B0); PG8_MMA(0, 1, At, B1); PG8_BAR; PG8_SCHED;
            PG8_LDA(At, 1, 1); PG8_STAGE(PG8_SB(1, 0), b3, voffB); PG8_STAGE(PG8_SB(1, 1), b3 + hstepB, voffB); PG8_STAGE(PG8_SA(1, 0), a3, voffA);
            PG8_WAIT_V(8); PG8_WAIT_L(0); PG8_BAR; PG8_MMA(1, 0, At, B0); PG8_MMA(1, 1, At, B1); PG8_BAR; PG8_SCHED;
            } else {
            PG8_LDB(B0, 0, 0); PG8_SCHED; PG8_LDA(At, 0, 0); PG8_STAGE(PG8_SA(1, 1), a1 + hstepA, voffA);
            PG8_WAIT_L(8); PG8_BAR; PG8_WAIT_L(0); PG8_MMA(0, 0, At, B0); PG8_BAR; PG8_SCHED;
            PG8_LDB(B1, 0, 1); PG8_STAGE(PG8_SB(0, 0), b2, voffB);
            PG8_BAR; PG8_WAIT_L(0); PG8_MMA(0, 1, At, B1); PG8_BAR;
            PG8_LDA(At, 0, 1); PG8_STAGE(PG8_SA(0, 0), a2, voffA);
            PG8_BAR; PG8_WAIT_L(0); PG8_MMA(1, 0, At, B0); PG8_BAR; PG8_SCHED;
            PG8_STAGE(PG8_SB(0, 1), b2 + hstepB, voffB);
            PG8_WAIT_V(6); PG8_BAR; PG8_MMA(1, 1, At, B1); PG8_BAR;
            PG8_LDB(B0, 1, 0); PG8_SCHED; PG8_LDA(At, 1, 0); PG8_STAGE(PG8_SA(0, 1), a2 + hstepA, voffA);
            PG8_WAIT_L(8); PG8_BAR; PG8_WAIT_L(0); PG8_MMA(0, 0, At, B0); PG8_BAR; PG8_SCHED;
            PG8_LDB(B1, 1, 1); PG8_STAGE(PG8_SB(1, 0), b3, voffB);
            PG8_BAR; PG8_WAIT_L(0); PG8_MMA(0, 1, At, B1); PG8_BAR;
            PG8_LDA(At, 1, 1); PG8_STAGE(PG8_SA(1, 0), a3, voffA);
            PG8_BAR; PG8_WAIT_L(0); PG8_MMA(1, 0, At, B0); PG8_BAR; PG8_SCHED;
            PG8_STAGE(PG8_SB(1, 1), b3 + hstepB, voffB);
            PG8_WAIT_V(6); PG8_BAR; PG8_MMA(1, 1, At, B1); PG8_BAR;
            }
        }
        if constexpr (ALIGN_EPI) { if (wr == 0) PG8_BAR; }
        if (!E.drain) { const int l2 = ltid() & 63; E(acc, cur, wr, wc, l2 & 15, l2 >> 4); S.done(cur); }
        if (!has_next) break;
#pragma unroll
        for (int a = 0; a < 2; ++a)
#pragma unroll
            for (int b = 0; b < 2; ++b)
#pragma unroll
                for (int m = 0; m < 4; ++m)
#pragma unroll
                    for (int n = 0; n < 2; ++n) acc[a][b][m][n] = (f32x4){0.f, 0.f, 0.f, 0.f};
        cur = nxt; cA = nA; cB = nB; ++ui;
        if constexpr (ALIGN_EPI) { if (wr == 1) PG8_BAR; }
    }
    PG8_WAIT_V(0);
    if constexpr (!ALIGN_EPI) { if (wr == 0) PG8_BAR; }
    PG8_BAR;
    if (E.drain) { const int l2 = ltid() & 63; E.fused(acc, cur, wr, wc, l2 & 15, l2 >> 4, lds, wid, l2); S.done(cur); }
#undef PG8_GOFF
#undef PG8_SA
#undef PG8_SB
#undef PG8_STAGE
#undef PG8_LDA
#undef PG8_LDB
#undef PG8_MMA
#undef PG8_WAIT_V
#undef PG8_WAIT_L
#undef PG8_BAR
#undef PG8_SCHED
}
}
namespace att {
enum { ORDER_NATURAL = 0, ORDER_REVERSED = 1, ORDER_PAIRED = 2, ORDER_XCD = 4 };
constexpr int B = 4, H = 16, HKV = 16, SQ = 2048, SKV = 2048, D = 128;
constexpr int QOFF = 0;
constexpr int WINDOW = SKV;
constexpr float THR = 8.f;
constexpr bool WSKIP = false;
constexpr float SCALE = 0.08838834764831845f;
constexpr int NW = 8, QBLK = 32, KVBLK = 64, QB = NW * QBLK;
constexpr int SHM_V = KVBLK * D * 2, SHM_K = KVBLK * D * 2;
constexpr int CS_OFF = 2 * SHM_V + 2 * SHM_K + NW * 64 * 4;
constexpr int QS_OFF = CS_OFF + SKV * 4;
constexpr int LDS_BYTES = QS_OFF + NW * 8192;
constexpr int OLD = 2048;
#ifndef ATT_QREG
#define ATT_QREG 8
#endif
constexpr int QREG = ATT_QREG;
static_assert(D == 128 && SQ % QB == 0 && SKV % KVBLK == 0 && H % HKV == 0 && QOFF >= 0 && QOFF + SQ <= SKV && WINDOW >= 1, "geometry");

using bf16 = __hip_bfloat16;
typedef short bf16x8 __attribute__((ext_vector_type(8)));
typedef short s16x4 __attribute__((ext_vector_type(4)));
typedef float f32x16 __attribute__((ext_vector_type(16)));
typedef float f32x4 __attribute__((ext_vector_type(4)));
typedef unsigned u32x4 __attribute__((ext_vector_type(4)));
template <class A, class Bt> struct same_t { static constexpr bool v = false; };
template <class A> struct same_t<A, A> { static constexpr bool v = true; };

#define LDSA __attribute__((address_space(3)))
typedef LDSA char lchar;
#define KSWZ(row, colB) ((row) * 256 + ((colB) ^ (((row) & 7) << 4)))
#define SBAR() __builtin_amdgcn_sched_barrier(0)
__device__ __forceinline__ int v_st(int k, int c) { const int kk = (k & ~0xC) | ((k & 4) << 1) | ((k & 8) >> 1); return ((kk >> 3) * 4 + (c >> 5)) * 512 + ((kk & 7) * 32 + (c & 31)) * 2; }
__device__ __forceinline__ int v_rd_base(int lane) { return ((lane & 3) << 3) | (((lane >> 2) & 3) << 6) | (((lane >> 4) & 1) << 5) | (((lane >> 5) & 1) << 8); }
constexpr int v_rd_off(int d0, int ks, int half) { return d0 * 512 + ks * 4096 + half * 2048; }
__device__ __forceinline__ int crow(int r, int hi) { return (r & 3) + 8 * (r >> 2) + 4 * hi; }
__device__ __forceinline__ unsigned cvtpk(float lo, float hi) {
    unsigned r; asm volatile("v_cvt_pk_bf16_f32 %0, %1, %2" : "=v"(r) : "v"(lo), "v"(hi)); return r;
}
__device__ __forceinline__ bf16x8 pack8(f32x4 a, f32x4 b) {
    u32x4 w = {cvtpk(a[0], a[1]), cvtpk(a[2], a[3]), cvtpk(b[0], b[1]), cvtpk(b[2], b[3])};
    return *reinterpret_cast<bf16x8*>(&w);
}
template <class T> __device__ __forceinline__ bf16x8 load8(const T* p) {
    if constexpr (same_t<T, float>::v) { return pack8(*(const f32x4*)p, *(const f32x4*)(p + 4)); }
    else { return *reinterpret_cast<const bf16x8*>(p); }
}
__device__ __forceinline__ void mask_tile(f32x16& p0, f32x16& p1, int dq, unsigned W) {
    const float NEG = -__builtin_inff();
#pragma unroll
    for (int r = 0; r < 16; ++r) {
        const int c = (r & 3) + 8 * (r >> 2);
        if ((unsigned)(dq - c) >= W) p0[r] = NEG;
        if ((unsigned)(dq - c - 32) >= W) p1[r] = NEG;
    }
}
__device__ __forceinline__ void partialSM(f32x16& p0, f32x16& p1, float& m_reg, float& mn, float& alpha) {
    float pmax = p0[0]; for (int r = 1; r < 16; ++r) pmax = fmaxf(pmax, p0[r]); for (int r = 0; r < 16; ++r) pmax = fmaxf(pmax, p1[r]);
    { auto rr = __builtin_amdgcn_permlane32_swap(__float_as_uint(pmax), __float_as_uint(pmax), false, false);
      pmax = fmaxf(__uint_as_float(rr[0]), __uint_as_float(rr[1])); }
    constexpr float C2 = 1.4426950408889634f * SCALE;
    if (__builtin_expect(__all((pmax - m_reg) * SCALE <= THR), 1)) { mn = m_reg; alpha = 1.f; }
    else { mn = fmaxf(m_reg, pmax); alpha = __builtin_amdgcn_exp2f((m_reg - mn) * C2); m_reg = mn; }
    const float mnL = -mn * C2;
    for (int r = 0; r < 16; ++r) p0[r] = fmaf(p0[r], C2, mnL); for (int r = 0; r < 16; ++r) p1[r] = fmaf(p1[r], C2, mnL);
    for (int r = 0; r < 16; ++r) p0[r] = __builtin_amdgcn_exp2f(p0[r]);
}
__device__ __forceinline__ void finishSM(f32x16& p0, f32x16& p1, float alpha, float& l_reg, bf16x8& pa0, bf16x8& pa1, bf16x8& pa2, bf16x8& pa3) {
    for (int r = 0; r < 16; ++r) p1[r] = __builtin_amdgcn_exp2f(p1[r]);
    float ps = 0; for (int r = 0; r < 16; ++r) ps += p0[r]; for (int r = 0; r < 16; ++r) ps += p1[r];
    { auto rr = __builtin_amdgcn_permlane32_swap(__float_as_uint(ps), __float_as_uint(ps), false, false);
      ps = __uint_as_float(rr[0]) + __uint_as_float(rr[1]); }
    l_reg = l_reg * alpha + ps;
#define PK4(P, B_, OUT) do { unsigned a0 = cvtpk(P[B_+0], P[B_+1]), a1 = cvtpk(P[B_+2], P[B_+3]);                          \
        unsigned b0 = cvtpk(P[B_+4], P[B_+5]), b1 = cvtpk(P[B_+6], P[B_+7]);                                             \
        auto r0 = __builtin_amdgcn_permlane32_swap(a0, b0, false, false); auto r1 = __builtin_amdgcn_permlane32_swap(a1, b1, false, false); \
        u32x4 w = {r0[0], r1[0], r0[1], r1[1]}; OUT = *reinterpret_cast<bf16x8*>(&w); } while (0)
    PK4(p0, 0, pa0); PK4(p0, 8, pa1); PK4(p1, 0, pa2); PK4(p1, 8, pa3);
#undef PK4
}
template <int KB, bool SK>
__device__ __forceinline__ void qkt(f32x16& p0, f32x16& p1, const lchar* K_lds, int r32, int hi, const lchar* qsl, const bf16x8* qh, bool act, const lchar* csb, float cqs) {
    if (SK && !act) { const float NEG = -__builtin_inff();
#pragma unroll
        for (int r = 0; r < 16; ++r) { p0[r] = NEG; p1[r] = NEG; } return; }
    { const LDSA f32x4* cb = (const LDSA f32x4*)csb;
#pragma unroll
      for (int j = 0; j < 4; ++j) { const f32x4 a = cb[2 * j], b = cb[2 * j + 8];
#pragma unroll
          for (int e = 0; e < 4; ++e) { p0[4 * j + e] = cqs - a[e]; p1[4 * j + e] = cqs - b[e]; } } }
    const lchar* kb[4];
#pragma unroll
    for (int dd = 0; dd < 4; ++dd) kb[dd] = K_lds + KB * SHM_K + KSWZ(r32, (dd * 16 + hi * 8) * 2);
#pragma unroll
    for (int d0 = 0; d0 < 8; ++d0) { const lchar* a = kb[d0 & 3] + (d0 >> 2) * 128;
        bf16x8 b0 = *(const LDSA bf16x8*)(a);
        bf16x8 b1 = *(const LDSA bf16x8*)(a + 32 * 256);
        const bf16x8 qf = (d0 < QREG) ? qh[d0] : *(const LDSA bf16x8*)(qsl + d0 * 1024);
        p0 = __builtin_amdgcn_mfma_f32_32x32x16_bf16(b0, qf, p0, 0, 0, 0);
        p1 = __builtin_amdgcn_mfma_f32_32x32x16_bf16(b1, qf, p1, 0, 0, 0); }
}
template <int VB, bool SK>
__device__ __forceinline__ void pv_tile(f32x16* o, int vb0, bf16x8 pa0, bf16x8 pa1, bf16x8 pa2, bf16x8 pa3, bool act) {
    if (SK && !act) return;
#define TRRD(dst, off) asm volatile("ds_read_b64_tr_b16 %0, %1 offset:%2" : "=&v"(dst) : "v"(vb0), "i"(off) : "memory")
#define PV_D0(d0) do { s16x4 l0, l1, l2, l3, h0, h1, h2, h3; constexpr int b_ = VB * SHM_V + v_rd_off(d0, 0, 0);     \
        TRRD(l0, b_); TRRD(h0, b_ + 2048); TRRD(l1, b_ + 4096); TRRD(h1, b_ + 6144); TRRD(l2, b_ + 8192); TRRD(h2, b_ + 10240); TRRD(l3, b_ + 12288); TRRD(h3, b_ + 14336); \
        asm volatile("s_waitcnt lgkmcnt(0)" ::: "memory"); SBAR();                 \
        o[d0] = __builtin_amdgcn_mfma_f32_32x32x16_bf16(pa0, (bf16x8){l0[0], l0[1], l0[2], l0[3], h0[0], h0[1], h0[2], h0[3]}, o[d0], 0, 0, 0);   \
        o[d0] = __builtin_amdgcn_mfma_f32_32x32x16_bf16(pa1, (bf16x8){l1[0], l1[1], l1[2], l1[3], h1[0], h1[1], h1[2], h1[3]}, o[d0], 0, 0, 0);   \
        o[d0] = __builtin_amdgcn_mfma_f32_32x32x16_bf16(pa2, (bf16x8){l2[0], l2[1], l2[2], l2[3], h2[0], h2[1], h2[2], h2[3]}, o[d0], 0, 0, 0);   \
        o[d0] = __builtin_amdgcn_mfma_f32_32x32x16_bf16(pa3, (bf16x8){l3[0], l3[1], l3[2], l3[3], h3[0], h3[1], h3[2], h3[3]}, o[d0], 0, 0, 0); } while (0)
    PV_D0(0); PV_D0(1); PV_D0(2); PV_D0(3);
#undef PV_D0
#undef TRRD
}

template <class TIn, class TOut> struct BlockRef { const TIn* Q; const TIn* K; const TIn* V; TOut* O; const TOut* OI; const float* CS; int P0; };
template <class TIn> struct Seam {
    bf16x8 qr[8];
    bf16x8 st_v0, st_v1, st_k0, st_k1; f32x4 sf0, sf1, sf2, sf3;
    f32x4 tq[16];
    f32x4 csv;
};
__device__ __forceinline__ int swa_jlo(int P0, int W) { const int lowk = P0 - W + 1; return lowk > 0 ? lowk / KVBLK : 0; }
__device__ __forceinline__ int swa_jhi(int P0, int skv) { int j = (P0 + QB - 1) / KVBLK + 1; return j > skv / KVBLK ? skv / KVBLK : j; }
#define ROW(p, k0, rr) ((p) + (size_t)((k0) + (rr)) * D + sc)
#define VMW() asm volatile("s_waitcnt vmcnt(0)" ::: "memory")
#define VMWN(n) asm volatile("s_waitcnt vmcnt(%0)" :: "i"(n) : "memory")
#define SLOAD_H(Kp, Vp, k0) do { S.st_v0 = load8<TIn>(ROW(Vp, k0, sr)); S.st_v1 = load8<TIn>(ROW(Vp, k0, 32 + sr));              \
                         S.st_k0 = load8<TIn>(ROW(Kp, k0, sr)); S.st_k1 = load8<TIn>(ROW(Kp, k0, 32 + sr)); } while (0)
#define SWRITE_HK(bf) do { *(LDSA bf16x8*)(K_lds + (bf) * SHM_K + kws) = S.st_k0; *(LDSA bf16x8*)(K_lds + (bf) * SHM_K + kws + 32 * 256) = S.st_k1; } while (0)
#define SWRITE_HV(bf) do { *(LDSA bf16x8*)(V_lds + (bf) * SHM_V + vst0) = S.st_v0; *(LDSA bf16x8*)(V_lds + (bf) * SHM_V + vst1) = S.st_v1; } while (0)
#define SWRITE_H(bf) do { SWRITE_HV(bf); SWRITE_HK(bf); } while (0)
#define SLOAD_F(p, k0) do { S.sf0 = *(const f32x4*)ROW(p, k0, sr); S.sf1 = *(const f32x4*)(ROW(p, k0, sr) + 4);                \
                            S.sf2 = *(const f32x4*)ROW(p, k0, 32 + sr); S.sf3 = *(const f32x4*)(ROW(p, k0, 32 + sr) + 4); } while (0)
#define SWRITE_KF(bf) do { *(LDSA bf16x8*)(K_lds + (bf) * SHM_K + kws) = pack8(S.sf0, S.sf1); *(LDSA bf16x8*)(K_lds + (bf) * SHM_K + kws + 32 * 256) = pack8(S.sf2, S.sf3); } while (0)
#define SWRITE_VF(bf) do { *(LDSA bf16x8*)(V_lds + (bf) * SHM_V + vst0) = pack8(S.sf0, S.sf1); *(LDSA bf16x8*)(V_lds + (bf) * SHM_V + vst1) = pack8(S.sf2, S.sf3); } while (0)
template <class TIn, class TOut>
__device__ __forceinline__ void causal_swa_prime(const BlockRef<TIn, TOut>& cur, int W, lchar* lds, Seam<TIn>& S) {
    constexpr bool F32 = same_t<TIn, float>::v;
    const int tid = ltid(), wid = __builtin_amdgcn_readfirstlane(tid >> 6), lane = tid & 63, r32 = lane & 31, hi = lane >> 5;
    const int sr = tid >> 4, sc = (tid & 15) * 8, kws = KSWZ(sr, sc * 2); lchar* K_lds = lds + 2 * SHM_V;
    const int kb0 = (swa_jhi(cur.P0, SKV) - 1) * KVBLK;
    for (int d0 = 0; d0 < 8; ++d0) S.qr[d0] = load8<TIn>(cur.Q + (size_t)(wid * QBLK + r32) * D + d0 * 16 + hi * 8);
    if constexpr (F32) { SLOAD_F((const float*)cur.K, kb0); VMW(); SWRITE_KF(0); SBAR(); SLOAD_F((const float*)cur.V, kb0); }
    else { SLOAD_H(cur.K, cur.V, kb0); S.csv = *(const f32x4*)(cur.CS + 4 * tid); VMW(); SWRITE_HK(0); *(LDSA f32x4*)(lds + CS_OFF + 16 * tid) = S.csv; }
    __syncthreads();
}
template <class TIn, class TOut>
__device__ __forceinline__ void causal_swa_block(const BlockRef<TIn, TOut>& cur, const BlockRef<TIn, TOut>& nxt, int skv, int W, lchar* lds, Seam<TIn>& S) {
    constexpr bool F32 = same_t<TIn, float>::v;
    const int tid = ltid(), wid = __builtin_amdgcn_readfirstlane(tid >> 6), lane = tid & 63, r32 = lane & 31, hi = lane >> 5;
    const int j_lo = swa_jlo(cur.P0, W);
    int j_hi = (cur.P0 + QB - 1) / KVBLK + 1; if (j_hi > skv / KVBLK) j_hi = skv / KVBLK;
    const int NT = j_hi - j_lo;
    const int kbn = (swa_jhi(nxt.P0, skv) - 1) * KVBLK;
    const int qlo = cur.P0 + wid * QBLK, qm = qlo + r32 - 4 * hi;
    lchar* V_lds = lds; lchar* K_lds = lds + 2 * SHM_V;
    LDSA float* ws = (LDSA float*)(lds + 2 * SHM_V + 2 * SHM_K) + wid * 64; LDSA float* li_l = ws; LDSA float* al_l = ws + 32;
    float m_reg = -1e30f, l_reg = 0; f32x16 o[4] = {};
    const lchar* cs_lds = lds + CS_OFF; const float cqs = ((const LDSA float*)cs_lds)[cur.P0 + wid * QBLK + r32]; const lchar* csl = cs_lds + hi * 16;
    lchar* qsl = lds + QS_OFF + wid * 8192 + lane * 16;
#pragma unroll
    for (int d0 = QREG; d0 < 8; ++d0) *(LDSA bf16x8*)(qsl + d0 * 1024) = S.qr[d0];
    bf16x8 qh[QREG > 0 ? QREG : 1];
#pragma unroll
    for (int d0 = 0; d0 < QREG; ++d0) qh[d0] = S.qr[d0];
    const int sr = tid >> 4, sc = (tid & 15) * 8, vst0 = v_st(sr, sc), vst1 = v_st(32 + sr, sc), kws = KSWZ(sr, sc * 2);
    const int vb0 = (int)(uintptr_t)V_lds + v_rd_base(lane);
    const TIn* Kh = cur.K; const TIn* Vh = cur.V;
#define RESC(a) do { if (__any((a) < 1.f)) { if (hi == 0) al_l[r32] = (a); asm volatile("s_waitcnt lgkmcnt(0)" ::: "memory");              \
                     for (int d_ = 0; d_ < 4; ++d_) for (int r = 0; r < 16; ++r) o[d_][r] *= al_l[crow(r, hi)]; } } while (0)
#define KBASE(t) ((j_hi - 1 - (t)) * KVBLK)
#define ACT(t) (KBASE(t) <= qlo + QBLK - 1 && KBASE(t) + KVBLK - 1 >= qlo - W + 1)
#define MASKT(P0_, P1_, t) do { const int kb_ = KBASE(t); if ((!SK || ACT(t)) && (kb_ + KVBLK - 1 > qlo || kb_ <= qlo + QBLK - 1 - W)) mask_tile(P0_, P1_, qm - kb_, (unsigned)W); } while (0)
    constexpr int NQL = F32 ? 16 : 8;
    constexpr bool SK = WSKIP && !F32;
#define SEAM_K0() do { VMWN(NQL); if constexpr (F32) { SWRITE_KF(0); SBAR(); SLOAD_F((const float*)nxt.V, kbn); } else { SWRITE_HK(0); *(LDSA f32x4*)(lds + CS_OFF + 16 * tid) = S.csv; } SBAR(); } while (0)
    f32x16 pA0, pA1, pB0, pB1; float mnA, mnB, alA, alB; bf16x8 pa0, pa1, pa2, pa3;
    if constexpr (F32) { VMW(); SWRITE_VF(0); SBAR(); } else { SWRITE_HV(0); SBAR(); }
    if (NT > 1) { if constexpr (F32) SLOAD_F((const float*)Kh, KBASE(1)); else SLOAD_H(Kh, Vh, KBASE(1)); }
    SBAR(); qkt<0, SK>(pA0, pA1, K_lds, r32, hi, qsl, qh, ACT(0), csl + KBASE(0) * 4, cqs);
    if constexpr (F32) { if (NT > 1) { VMW(); SWRITE_KF(1); SBAR(); SLOAD_F((const float*)Vh, KBASE(1)); } }
    MASKT(pA0, pA1, 0); partialSM(pA0, pA1, m_reg, mnA, alA);
    if (NT > 1) { VMW(); if constexpr (F32) { SWRITE_VF(1); SBAR(); if (NT > 2) SLOAD_F((const float*)Kh, KBASE(2)); } else SWRITE_H(1); }
    __syncthreads();
#define HALF_STEP(PX0, PX1, mnX, alX, PY0, PY1, alY, t, KB, VB, SB) do {                                                      \
        SBAR(); qkt<KB, SK>(PX0, PX1, K_lds, r32, hi, qsl, qh, ACT(t), csl + KBASE(t) * 4, cqs);                                             \
        finishSM(PY0, PY1, alY, l_reg, pa0, pa1, pa2, pa3); SBAR();                                                           \
        if ((t) + 1 < NT) { if constexpr (F32) { VMW(); SWRITE_KF(SB); SBAR(); SLOAD_F((const float*)Vh, KBASE((t) + 1)); }  \
                            else { SLOAD_H(Kh, Vh, KBASE((t) + 1)); } SBAR(); }                                               \
        pv_tile<VB, SK>(o, vb0, pa0, pa1, pa2, pa3, ACT((t) - 1)); MASKT(PX0, PX1, (t)); partialSM(PX0, PX1, m_reg, mnX, alX);                                        \
        __syncthreads();                                                                                                      \
        if ((t) + 1 < NT) { VMW(); if constexpr (F32) { SWRITE_VF(SB); SBAR(); if ((t) + 2 < NT) SLOAD_F((const float*)Kh, KBASE((t) + 2)); } \
                            else { SWRITE_H(SB); } }                                                                          \
        RESC(alX); __syncthreads(); } while (0)
    for (int t = 1; t + 1 < NT; t += 2) {
        HALF_STEP(pB0, pB1, mnB, alB, pA0, pA1, alA, t, 1, 0, 0);
        HALF_STEP(pA0, pA1, mnA, alA, pB0, pB1, alB, t + 1, 0, 1, 1);
    }
    const bool even = (NT & 1) == 0;
    if (even) { SBAR(); qkt<1, SK>(pB0, pB1, K_lds, r32, hi, qsl, qh, ACT(NT - 1), csl + KBASE(NT - 1) * 4, cqs); SBAR(); }
#define QROW(e) (nxt.Q + (size_t)(wid * QBLK + r32) * D + ((e) >> 1) * 16 + hi * 8 + ((e) & 1) * 4)
    if constexpr (F32) { SLOAD_F((const float*)nxt.K, kbn); SBAR();
#pragma unroll
        for (int e = 0; e < 8; ++e) S.tq[e] = *(const f32x4*)QROW(e); }
    else { S.csv = *(const f32x4*)(nxt.CS + 4 * tid); SLOAD_H(nxt.K, nxt.V, kbn); SBAR();
#pragma unroll
        for (int d0 = 0; d0 < 8; ++d0) S.qr[d0] = load8<TIn>(nxt.Q + (size_t)(wid * QBLK + r32) * D + d0 * 16 + hi * 8); }
    SBAR();
    finishSM(pA0, pA1, alA, l_reg, pa0, pa1, pa2, pa3); SBAR();
    if constexpr (F32) {
#pragma unroll
        for (int e = 8; e < 16; ++e) S.tq[e] = *(const f32x4*)QROW(e); SBAR(); }
#undef QROW
    pv_tile<0, SK>(o, vb0, pa0, pa1, pa2, pa3, ACT(even ? NT - 2 : NT - 1));
    if (even) { MASKT(pB0, pB1, NT - 1); partialSM(pB0, pB1, m_reg, mnB, alB); __syncthreads(); RESC(alB);
        finishSM(pB0, pB1, alB, l_reg, pa0, pa1, pa2, pa3); SBAR(); pv_tile<1, SK>(o, vb0, pa0, pa1, pa2, pa3, ACT(NT - 1)); }
    SBAR(); SEAM_K0();
    if (hi == 0) li_l[r32] = l_reg; asm volatile("s_waitcnt lgkmcnt(0)" ::: "memory");
    float rli[16];
#pragma unroll
    for (int r = 0; r < 16; ++r) rli[r] = __builtin_amdgcn_rcpf(li_l[crow(r, hi)]);
    TOut* Ow = cur.O + (size_t)(wid * QBLK) * OLD; const TOut* OIw = cur.OI + (size_t)(wid * QBLK) * OLD;
#pragma unroll
    for (int r = 0; r < 16; ++r) { const int orow = crow(r, hi);
#pragma unroll
        for (int d0 = 0; d0 < 4; ++d0) { const float v = o[d0][r] * rli[r];
            if constexpr (same_t<TOut, float>::v) { Ow[(size_t)orow * OLD + d0 * 32 + r32] = v; }
            else { const float vn = __shfl_xor(v, 1);
                   if ((r32 & 1) == 0) { const size_t eo = (size_t)orow * OLD + d0 * 32 + r32; unsigned* pp = (unsigned*)(Ow + eo); const unsigned sp = *(const unsigned*)(OIw + eo);
                       *pp = cvtpk(v * __uint_as_float(sp << 16), vn * __uint_as_float(sp & 0xffff0000u)); } } } }
    if constexpr (F32) {
#pragma unroll
        for (int d0 = 0; d0 < 8; ++d0) S.qr[d0] = pack8(S.tq[2 * d0], S.tq[2 * d0 + 1]); }
    __syncthreads();
#undef RESC
#undef KBASE
#undef ACT
#undef MASKT
#undef SEAM_K0
#undef HALF_STEP
}
#undef ROW
#undef VMW
#undef VMWN
#undef SLOAD_H
#undef SWRITE_HK
#undef SWRITE_HV
#undef SWRITE_H
#undef SLOAD_F
#undef SWRITE_KF
#undef SWRITE_VF

}
namespace mk {
typedef unsigned short bf16_t;
typedef float f32x4 __attribute__((ext_vector_type(4)));
typedef float f32x2 __attribute__((ext_vector_type(2)));
typedef unsigned u32x4 __attribute__((ext_vector_type(4)));
typedef unsigned u32x2 __attribute__((ext_vector_type(2)));
typedef short bf16x8 __attribute__((ext_vector_type(8)));
typedef float f32x16 __attribute__((ext_vector_type(16)));
#define LAS __attribute__((address_space(3)))
typedef LAS float __attribute__((may_alias)) f32_ma;
typedef LAS unsigned short __attribute__((may_alias)) u16_ma;
typedef LAS unsigned __attribute__((may_alias)) u32_ma;
typedef LAS bf16x8 __attribute__((may_alias)) bf16x8_ma;
constexpr int MTOK = 8192, DM = 2048, SEQ = 2048;
constexpr int LDS_BYTES = 147456;
constexpr int NPHASE = 17;
constexpr size_t MiB = 1u << 20, KiB = 1u << 10;
constexpr size_t WS_W_S5IN = 0, WS_W_FOXIN = 32 * MiB, WS_W_POOLIN = 64 * MiB, WS_W_OUT = 80 * MiB, WS_W_GLU = 112 * MiB, WS_W_POOLG = 128 * MiB;
constexpr size_t WS_MISC = 130 * MiB, WS_HB = 136 * MiB, WS_U = 168 * MiB, WS_K = 200 * MiB, WS_V = 232 * MiB, WS_SZ = 264 * MiB, WS_HL = 296 * MiB, WS_END = (RESID_MODE == 2 ? 328 : 296) * MiB;
static_assert(WS_K - WS_U == 32 * MiB && WS_V - WS_K == 32 * MiB && WS_SZ - WS_V == 32 * MiB, "Epi::OSTR");
constexpr size_t MS_SSQ = 4096 * KiB  , MS_FLOG = 128 * KiB, MS_CS = 640 * KiB, MS_WF = 1152 * KiB, MS_ABAR = 1280 * KiB, MS_BBAR = 1408 * KiB, MS_CM = 2432 * KiB, MS_BAR = 3456 * KiB, BAR_BYTES = 49152;
struct Params { const float* in[21]; float* out; unsigned char* ws; int ph_lo, ph_hi; };

__device__ __forceinline__ unsigned f2bf(float f) { unsigned u = __float_as_uint(f); return (u + 0x7fffu + ((u >> 16) & 1u)) >> 16; }
__device__ __forceinline__ unsigned pk2(float lo, float hi) { return f2bf(lo) | (f2bf(hi) << 16); }
__device__ __forceinline__ float wave_sum(float v) {
#pragma unroll
    for (int o = 1; o < 64; o <<= 1) v += __shfl_xor(v, o);
    return v;
}
__device__ __forceinline__ int crow(int r, int hi) { return (r & 3) + 8 * (r >> 2) + 4 * hi; }

__device__ __forceinline__ void transpose_item(const float* W, int ldw, int K, int N, const float* kscale, bf16_t* WT, LAS float* scr, int item, int lane) {
    const int nblk = N / 64, kb = item / nblk, nb = item % nblk, k0 = 64 * kb, n0 = 64 * nb, r4 = lane >> 4, c4 = (lane & 15) * 4;
    f32x4 v[16];
#pragma unroll
    for (int i = 0; i < 16; ++i) v[i] = *(const f32x4*)(W + (size_t)(k0 + 4 * i + r4) * ldw + n0 + c4);
    if (kscale) {
#pragma unroll
        for (int i = 0; i < 16; ++i) v[i] = v[i] * kscale[k0 + 4 * i + r4]; }
#pragma unroll
    for (int i = 0; i < 16; ++i) { LAS float* d = scr + (4 * i + r4) * 65 + c4; d[0] = v[i][0]; d[1] = v[i][1]; d[2] = v[i][2]; d[3] = v[i][3]; }
    asm volatile("s_waitcnt lgkmcnt(0)" ::: "memory");
    const int c = lane & 7;
#pragma unroll
    for (int j = 0; j < 8; ++j) { const int n = (lane >> 3) + 8 * j; const LAS float* s = scr + (8 * c) * 65 + n;
        u32x4 o; o.x = pk2(s[0 * 65], s[1 * 65]); o.y = pk2(s[2 * 65], s[3 * 65]); o.z = pk2(s[4 * 65], s[5 * 65]); o.w = pk2(s[6 * 65], s[7 * 65]);
        *(u32x4*)(WT + (size_t)(n0 + n) * K + k0 + 8 * c) = o; }
    asm volatile("s_waitcnt lgkmcnt(0)" ::: "memory");
}
__device__ __forceinline__ double exp_small(double x) { double s = 1.0, t = 1.0;
#pragma unroll
    for (int n = 1; n <= 14; ++n) { t *= x * (1.0 / n); s += t; } return s; }
__device__ __forceinline__ double exp_d(double x) { double y = exp_small(x * (1.0 / 64.0));
#pragma unroll
    for (int i = 0; i < 6; ++i) y *= y; return y; }
__device__ __forceinline__ void sincos_d(double th, double& sn, double& cs) {
    const double k = __builtin_rint(th * 0.63661977236758134308);
    const double r = __builtin_fma(-k, 6.123233995736766e-17, __builtin_fma(-k, 1.5707963267948966, th)), r2 = r * r;
    double ts = r, ss = r, tc = 1.0, sc = 1.0;
#pragma unroll
    for (int n = 1; n <= 9; ++n) { tc *= -r2 * (1.0 / ((2 * n - 1) * (2 * n))); sc += tc; ts *= -r2 * (1.0 / ((2 * n) * (2 * n + 1))); ss += ts; }
    const int q = ((int)k) & 3;
    sn = (q == 0) ? ss : (q == 1) ? sc : (q == 2) ? -ss : -sc;
    cs = (q == 0) ? sc : (q == 1) ? -ss : (q == 2) ? -sc : ss;
}
#define PROIN(i) ((const float*)(const __attribute__((address_space(1))) float*)Pk->in[i])
__device__ __forceinline__ void transpose_dispatch(const __attribute__((address_space(4))) Params* Pk, LAS unsigned char* lds, int it, int wid, int lane) {
    unsigned char* ws = (unsigned char*)(__attribute__((address_space(1))) unsigned char*)Pk->ws;
    const float* normw = PROIN(1);
    LAS float* scr = (LAS float*)(lds + wid * 16640);
    int r = it;
    if (r < 4096) { const int j = r >> 11; transpose_item(PROIN(3) + (size_t)j * 2048 * 4096, 4096, 2048, 4096, normw + 3 * j * 2048, (bf16_t*)(ws + WS_W_S5IN) + (size_t)j * 4096 * 2048, scr, r & 2047, lane); return; } r -= 4096;
    if (r < 4096) { transpose_item(PROIN(14), 8208, 2048, 8192, normw + 2048, (bf16_t*)(ws + WS_W_FOXIN), scr, r, lane); return; } r -= 4096;
    if (r < 2048) { transpose_item(PROIN(18), 4096, 2048, 4096, normw + 2 * 2048, (bf16_t*)(ws + WS_W_POOLIN), scr, r, lane); return; } r -= 2048;
    if (r < 4096) { const int i = r >> 10; transpose_item(PROIN(2) + (size_t)i * 2048 * 2048, 2048, 2048, 2048, nullptr, (bf16_t*)(ws + WS_W_OUT) + (size_t)i * 2048 * 2048, scr, r & 1023, lane); return; } r -= 4096;
    if (r < 2048) { const int j = r >> 10; transpose_item(PROIN(12) + (size_t)j * 2048 * 2048, 2048, 2048, 2048, nullptr, (bf16_t*)(ws + WS_W_GLU) + (size_t)j * 2048 * 2048, scr, r & 1023, lane); return; } r -= 2048;
    { const int g = r >> 6; transpose_item(PROIN(19) + (size_t)g * 512 * 512, 512, 512, 512, nullptr, (bf16_t*)(ws + WS_W_POOLG) + (size_t)g * 512 * 512, scr, r & 63, lane); }
}
__device__ __forceinline__ void convert_rest(const __attribute__((address_space(4))) Params* Pk, LAS unsigned char* lds, int k0, int k1, int vb, int vg) {
    const int tid = ltid(), lane = tid & 63, wid = __builtin_amdgcn_readfirstlane(tid >> 6);
    for (int k = k0 + vb * 8 + wid; k < k1; k += vg * 8) {
        int r = k, it;
        if (r < 2048) it = 2048 + r; else { r -= 2048;
        if (r < 4096) it = 4096 + r; else { r -= 4096;
        if (r < 2048) it = 8192 + r; else { r -= 2048;
        if (r < 3072) it = 11264 + r; else { r -= 3072;
        if (r < 1024) it = 15360 + r; else it = 16384 + (r - 1024); } } } }
        transpose_dispatch(Pk, lds, it, wid, lane);
    }
}
__device__ __forceinline__ void prologue(const __attribute__((address_space(4))) Params* Pk, LAS unsigned char* lds) {
    const int tid = ltid(), lane = tid & 63, wid = __builtin_amdgcn_readfirstlane(tid >> 6);
    const int gw = lbid() * 8 + wid, NGW = lgrid() * 8, gt = lbid() * 512 + tid, NGT = lgrid() * 512;
    unsigned char* ws = (unsigned char*)(__attribute__((address_space(1))) unsigned char*)Pk->ws;
    const float* normw = PROIN(1);
    for (int k = gw; k < 4096; k += NGW)
        transpose_dispatch(Pk, lds, k < 2048 ? k : (k < 3072 ? 10240 + (k - 2048) : 14336 + (k - 3072)), wid, lane);
    { float* WF = (float*)(ws + WS_MISC + MS_WF); float* ssq = (float*)(ws + WS_MISC + MS_SSQ);
      bf16_t* WFb = (bf16_t*)WF;
      for (int i = gt; i < 65536; i += NGT) { const int k = i >> 5, h = i & 31; WFb[h * 2048 + k] = h < 16 ? (bf16_t)f2bf(PROIN(14)[(size_t)k * 8208 + 8192 + h] * normw[2048 + k]) : (bf16_t)0; }
      (void)ssq; }
    { bf16_t* HB = (bf16_t*)(ws + WS_HB); float* ssq = (float*)(ws + WS_MISC + MS_SSQ); const float* x = PROIN(0);
      for (int m = gw; m < MTOK; m += NGW) { const f32x4* xr = (const f32x4*)(x + (size_t)m * DM) + lane; float s = 0.f; u32x2* o = (u32x2*)(HB + (size_t)m * DM) + lane;
#pragma unroll
          for (int j = 0; j < 8; ++j) { const f32x4 v = xr[64 * j]; s += (v.x * v.x + v.y * v.y) + (v.z * v.z + v.w * v.w); o[64 * j] = (u32x2){pk2(v.x, v.y), pk2(v.z, v.w)}; }
          s = wave_sum(s); if (lane < 8) ssq[(size_t)m * 8 + lane] = lane == 0 ? s : 0.f; } }
    { float* abar = (float*)(ws + WS_MISC + MS_ABAR); bf16_t* bbarT = (bf16_t*)(ws + WS_MISC + MS_BBAR); bf16_t* cmT = (bf16_t*)(ws + WS_MISC + MS_CM);
      for (int it = gw; it < 256; it += NGW) { const int jg = it, p = lane;
          const double dt = exp_d((double)PROIN(6)[jg]);
          const double ar = (double)PROIN(4)[jg * 64 + p], ai = (double)PROIN(5)[jg * 64 + p];
          const double mag = exp_d(ar * dt); double sn, cs; sincos_d(ai * dt, sn, cs);
          const double abr = mag * cs, abi = mag * sn, den = ar * ar + ai * ai, xr = abr - 1.0;
          const double fr = (xr * ar + abi * ai) / den, fi = (abi * ar - xr * ai) / den;
          abar[(jg * 64 + p) * 2] = (float)abr; abar[(jg * 64 + p) * 2 + 1] = (float)abi;
          const float* br = PROIN(7) + (size_t)(jg * 64 + p) * 16; const float* bi = PROIN(8) + (size_t)(jg * 64 + p) * 16;
          unsigned wr_[8], wi_[8];
#pragma unroll
          for (int c = 0; c < 8; ++c) { const double r0 = br[2 * c], i0 = bi[2 * c], r1 = br[2 * c + 1], i1 = bi[2 * c + 1];
              wr_[c] = pk2((float)(fr * r0 - fi * i0), (float)(fr * r1 - fi * i1)); wi_[c] = pk2((float)(fr * i0 + fi * r0), (float)(fr * i1 + fi * r1)); }
          u32x4* dr = (u32x4*)(bbarT + ((size_t)jg * 128 + p) * 16); u32x4* di = (u32x4*)(bbarT + ((size_t)jg * 128 + 64 + p) * 16);
          dr[0] = (u32x4){wr_[0], wr_[1], wr_[2], wr_[3]}; dr[1] = (u32x4){wr_[4], wr_[5], wr_[6], wr_[7]};
          di[0] = (u32x4){wi_[0], wi_[1], wi_[2], wi_[3]}; di[1] = (u32x4){wi_[4], wi_[5], wi_[6], wi_[7]};
#pragma unroll
          for (int c = 0; c < 16; ++c) { const size_t ci = ((size_t)jg * 16 + c) * 64 + p;
              ((unsigned*)cmT)[((size_t)jg * 16 + c) * 64 + p] = pk2(PROIN(9)[ci], -PROIN(10)[ci]); }
      } }
}

__device__ __forceinline__ float gelu_tanh(float x) { const float p = __builtin_fmaf(x * x, -0.10294324f, -2.30220819f); return x * __builtin_amdgcn_rcpf(1.f + __builtin_amdgcn_exp2f(p * x)); }
typedef LAS f32x4 __attribute__((may_alias)) f32x4_ma;
template <bool OUT>
__device__ __forceinline__ void s5_chunks(LAS unsigned char* buf, const bf16_t* Ug, bf16_t* Gg, const bf16x8 (&bfrag)[4], const bf16x8 (&cfrag)[8], const f32x4 da, const f32x4 db,
                                          float ar, float ai, float& hr, float& hi_, int lane, int r32, int hi) {
    LAS unsigned char* Hb = buf + 8192;
    const int swz = (lane >> 2) & 3, wsw = (r32 >> 2) & 3;
    const LAS unsigned char* rre = buf + lane * 64; const LAS unsigned char* rim = buf + (64 + lane) * 64;
    bf16x8 a_nx = *(const bf16x8*)(Ug + (size_t)r32 * DM + hi * 8);
    for (int c = 0; c < 16; ++c) {
        const bf16x8 a = a_nx;
        if (c + 1 < 16) a_nx = *(const bf16x8*)(Ug + (size_t)((c + 1) * 32 + r32) * DM + hi * 8);
        const size_t ro = (size_t)(c * 32 + r32) * DM + 4 * hi;
        u32x2 ua = {0u, 0u}, ub = {0u, 0u};
        if (OUT) { ua = *(const u32x2*)(Ug + ro); ub = *(const u32x2*)(Ug + ro + 8); }
        f32x16 d[4];
#pragma unroll
        for (int jt = 0; jt < 4; ++jt) { d[jt] = f32x16{}; d[jt] = __builtin_amdgcn_mfma_f32_32x32x16_bf16(a, bfrag[jt], d[jt], 0, 0, 0); }
#pragma unroll
        for (int hh = 0; hh < 2; ++hh) {
#pragma unroll
            for (int jt = 0; jt < 4; ++jt)
#pragma unroll
                for (int rg = 0; rg < 2; ++rg) { const int r0 = 8 * hh + 4 * rg;
                    *(f32x4_ma*)(buf + (jt * 32 + r32) * 64 + (((2 * rg + hi) ^ wsw) * 16)) = (f32x4){d[jt][r0], d[jt][r0 + 1], d[jt][r0 + 2], d[jt][r0 + 3]}; }
            f32x4 R[4], I[4];
#pragma unroll
            for (int j = 0; j < 4; ++j) { R[j] = *(const f32x4_ma*)(rre + ((j ^ swz) * 16)); I[j] = *(const f32x4_ma*)(rim + ((j ^ swz) * 16)); }
#pragma unroll
            for (int q = 0; q < 4; ++q) {
                LAS unsigned char* rw = Hb + (16 * hh + 4 * q) * 272;
#pragma unroll
                for (int k = 0; k < 4; ++k) {
                    const float nr = __builtin_fmaf(ar, hr, __builtin_fmaf(-ai, hi_, R[q][k])), ni = __builtin_fmaf(ar, hi_, __builtin_fmaf(ai, hr, I[q][k])); hr = nr; hi_ = ni;
                    if (OUT) ((u32_ma*)(rw + 272 * k))[lane] = pg8::cvt_pk_bf16(hr, hi_);
                }
            }
        }
        if (OUT) {
            f32x16 y = {};
#pragma unroll
            for (int kk = 0; kk < 8; ++kk) { const bf16x8 hf = *(const bf16x8_ma*)(Hb + r32 * 272 + (kk * 16 + hi * 8) * 2); y = __builtin_amdgcn_mfma_f32_32x32x16_bf16(cfrag[kk], hf, y, 0, 0, 0); }
            const float a0 = gelu_tanh(y[0] + da[0] * pg8::bf_lo(ua.x)), a1 = gelu_tanh(y[1] + da[1] * pg8::bf_hi(ua.x)), a2 = gelu_tanh(y[2] + da[2] * pg8::bf_lo(ua.y)), a3 = gelu_tanh(y[3] + da[3] * pg8::bf_hi(ua.y));
            const float b0 = gelu_tanh(y[4] + db[0] * pg8::bf_lo(ub.x)), b1 = gelu_tanh(y[5] + db[1] * pg8::bf_hi(ub.x)), b2 = gelu_tanh(y[6] + db[2] * pg8::bf_lo(ub.y)), b3 = gelu_tanh(y[7] + db[3] * pg8::bf_hi(ub.y));
            *(u32x2*)(Gg + ro) = (u32x2){pg8::cvt_pk_bf16(a0, a1), pg8::cvt_pk_bf16(a2, a3)}; *(u32x2*)(Gg + ro + 8) = (u32x2){pg8::cvt_pk_bf16(b0, b1), pg8::cvt_pk_bf16(b2, b3)};
        }
    }
}
__device__ __forceinline__ void s5_pass1_direct(const bf16_t* Ug, const bf16x8 (&bfrag)[4], const float* abg  , float& hr, float& hi_, int lane, int r32, int hi) {
    float wr[2][16], wi[2][16], a32r[2], a32i[2];
#pragma unroll
    for (int s = 0; s < 2; ++s) {
        const float ar = abg[(32 * s + r32) * 2], ai = abg[(32 * s + r32) * 2 + 1];
        float pr[32], pi[32]; pr[0] = 1.f; pi[0] = 0.f;
#pragma unroll
        for (int k = 1; k < 32; ++k) { pr[k] = pr[k - 1] * ar - pi[k - 1] * ai; pi[k] = pr[k - 1] * ai + pi[k - 1] * ar; }
        a32r[s] = pr[31] * ar - pi[31] * ai; a32i[s] = pr[31] * ai + pi[31] * ar;
#pragma unroll
        for (int r = 0; r < 16; ++r) { const int k0 = 31 - (r & 3) - 8 * (r >> 2); wr[s][r] = hi ? pr[k0 - 4] : pr[k0]; wi[s][r] = hi ? pi[k0 - 4] : pi[k0]; }
    }
    float Er[2] = {0.f, 0.f}, Ei[2] = {0.f, 0.f};
    bf16x8 a_nx = *(const bf16x8*)(Ug + (size_t)r32 * DM + hi * 8);
    for (int c = 0; c < 16; ++c) {
        const bf16x8 a = a_nx;
        if (c + 1 < 16) a_nx = *(const bf16x8*)(Ug + (size_t)((c + 1) * 32 + r32) * DM + hi * 8);
        f32x16 d[4];
#pragma unroll
        for (int jt = 0; jt < 4; ++jt) { d[jt] = f32x16{}; d[jt] = __builtin_amdgcn_mfma_f32_32x32x16_bf16(a, bfrag[jt], d[jt], 0, 0, 0); }
#pragma unroll
        for (int s = 0; s < 2; ++s) {
            float er = 0.f, ei = 0.f;
#pragma unroll
            for (int r = 0; r < 16; ++r) { const float br = d[s][r], bi = d[2 + s][r];
                er = __builtin_fmaf(wr[s][r], br, __builtin_fmaf(-wi[s][r], bi, er)); ei = __builtin_fmaf(wr[s][r], bi, __builtin_fmaf(wi[s][r], br, ei)); }
            { auto r0 = __builtin_amdgcn_permlane32_swap(__float_as_uint(er), __float_as_uint(er), false, false); er = __uint_as_float(r0[0]) + __uint_as_float(r0[1]);
              auto r1 = __builtin_amdgcn_permlane32_swap(__float_as_uint(ei), __float_as_uint(ei), false, false); ei = __uint_as_float(r1[0]) + __uint_as_float(r1[1]); }
            const float nr = __builtin_fmaf(a32r[s], Er[s], __builtin_fmaf(-a32i[s], Ei[s], er)), ni = __builtin_fmaf(a32r[s], Ei[s], __builtin_fmaf(a32i[s], Er[s], ei)); Er[s] = nr; Ei[s] = ni;
        }
    }
    hr = lane < 32 ? Er[0] : Er[1]; hi_ = lane < 32 ? Ei[0] : Ei[1];
}
__device__ __forceinline__ void s5_phase(LAS unsigned char* lds, const bf16_t* U, bf16_t* G, const float* abar, const bf16_t* bbarT, const bf16_t* cmT, const float* dskip, int p0, int p1, int pstride) {
    const int tid = ltid(), lane = tid & 63, wid = __builtin_amdgcn_readfirstlane(tid >> 6), r32 = lane & 31, hi = lane >> 5;
    LAS unsigned char* buf = lds + wid * 16896; f32_ma* ex = (f32_ma*)(lds + 8 * 16896);
    for (int pair = p0; pair < p1; pair += pstride) {
        const int bg = pair * 2 + (wid >> 2), seg = wid & 3, b = bg >> 7, g = bg & 127;
        const float ar = abar[(g * 64 + lane) * 2], ai = abar[(g * 64 + lane) * 2 + 1];
        bf16x8 bfrag[4], cfrag[8];
#pragma unroll
        for (int jt = 0; jt < 4; ++jt) bfrag[jt] = *(const bf16x8*)(bbarT + ((size_t)g * 128 + jt * 32 + r32) * 16 + hi * 8);
        const size_t rowbase = (size_t)b * SEQ + seg * 512;
        const bf16_t* Ug = U + rowbase * DM + g * 16; bf16_t* Gg = G + rowbase * DM + g * 16;
        float hr = 0.f, hi_ = 0.f;
        if (seg != 3) s5_pass1_direct(Ug, bfrag, abar + (size_t)g * 64 * 2, hr, hi_, lane, r32, hi);
        ex[(wid * 64 + lane) * 2] = hr; ex[(wid * 64 + lane) * 2 + 1] = hi_;
        __syncthreads();
        asm volatile("" ::: "memory");
#pragma unroll
        for (int kk = 0; kk < 8; ++kk) { cfrag[kk] = (bf16x8){0, 0, 0, 0, 0, 0, 0, 0}; if (r32 < 16) cfrag[kk] = *(const bf16x8*)(cmT + ((size_t)g * 16 + r32) * 128 + kk * 16 + hi * 8); }
        const f32x4 da = *(const f32x4*)(dskip + g * 16 + 4 * hi), db = *(const f32x4*)(dskip + g * 16 + 8 + 4 * hi);
        float pr = ar, pi = ai;
#pragma unroll
        for (int i = 0; i < 9; ++i) { const float nr = pr * pr - pi * pi, ni = 2.f * pr * pi; pr = nr; pi = ni; }
        hr = 0.f; hi_ = 0.f;
        for (int s = 0; s < seg; ++s) { const float er = ex[(((wid & 4) + s) * 64 + lane) * 2], ei = ex[(((wid & 4) + s) * 64 + lane) * 2 + 1];
            const float nr = pr * hr - pi * hi_ + er, ni = pr * hi_ + pi * hr + ei; hr = nr; hi_ = ni; }
        s5_chunks<true>(buf, Ug, Gg, bfrag, cfrag, da, db, ar, ai, hr, hi_, lane, r32, hi);
        __syncthreads();
    }
}

__device__ __forceinline__ void flog_phase(LAS unsigned char* lds, const bf16_t* h, const float* ssq, const bf16_t* WFb, const float* fbias, float* flog, int r0, int r1, int rstride) {
    const int tid = ltid(), lane = tid & 63, wid = __builtin_amdgcn_readfirstlane(tid >> 6), r32 = lane & 31, hi = lane >> 5;
    LAS float* part = (LAS float*)lds;
    for (int rb = r0; rb < r1; rb += rstride) {
        const bf16_t* ap = h + (size_t)(rb * 32 + r32) * DM + wid * 256 + hi * 8;
        const bf16_t* bp = WFb + (size_t)r32 * DM + wid * 256 + hi * 8;
        bf16x8 a[16], b[16];
#pragma unroll
        for (int i = 0; i < 16; ++i) { a[i] = *(const bf16x8*)(ap + i * 16); b[i] = *(const bf16x8*)(bp + i * 16); }
        f32x16 d = {};
#pragma unroll
        for (int i = 0; i < 16; ++i) d = __builtin_amdgcn_mfma_f32_32x32x16_bf16(a[i], b[i], d, 0, 0, 0);
#pragma unroll
        for (int r = 0; r < 16; ++r) part[(wid * 32 + crow(r, hi)) * 33 + r32] = d[r];
        __syncthreads();
        { const int row = tid >> 4, hh = tid & 15; float v = 0.f;
#pragma unroll
          for (int w = 0; w < 8; ++w) v += part[(w * 32 + row) * 33 + hh];
          const int grow = rb * 32 + row;
          const f32x4 q0 = *(const f32x4*)(ssq + (size_t)grow * 8), q1 = *(const f32x4*)(ssq + (size_t)grow * 8 + 4);
          const float f = v * rsqrtf((((q0[0] + q0[1]) + (q0[2] + q0[3])) + ((q1[0] + q1[1]) + (q1[2] + q1[3]))) * (1.0f / 2048.0f) + 1e-6f) + fbias[hh];
          flog[(size_t)grow * 16 + hh] = fminf(f, 0.f) - __logf(1.f + __expf(-fabsf(f))); }
        __syncthreads();
    }
}
__device__ __forceinline__ void cs_qknorm_phase(LAS unsigned char* lds, const float* flog, float* cs, bf16_t* Q, bf16_t* K, const float* qw, const float* kw, int half, int vb, int vg) {
    const int tid = ltid(), lane = tid & 63, wid = __builtin_amdgcn_readfirstlane(tid >> 6);
    f32_ma* red = (f32_ma*)lds;
    for (int seq = 32 * half + vb; seq < 32 * half + 32; seq += vg) {
        const int b = seq >> 4, hh = seq & 15; float v[4];
#pragma unroll
        for (int i = 0; i < 4; ++i) v[i] = flog[((size_t)b * SEQ + 4 * tid + i) * 16 + hh];
        v[1] += v[0]; v[2] += v[1]; v[3] += v[2];
        float inc = v[3];
#pragma unroll
        for (int o = 1; o < 64; o <<= 1) { const float n = __shfl_up(inc, o); if (lane >= o) inc += n; }
        if (lane == 63) red[wid] = inc;
        __syncthreads();
        float base = 0.f;
        for (int w = 0; w < wid; ++w) base += red[w];
        const float ex = base + inc - v[3], inv = 11.313708498984761f;
        *(f32x4*)(cs + (size_t)seq * SEQ + 4 * tid) = (f32x4){(ex + v[0]) * inv, (ex + v[1]) * inv, (ex + v[2]) * inv, (ex + v[3]) * inv};
        __syncthreads();
    }
    const int gw = vb * 8 + wid, NGW = vg * 8, sub = lane >> 4, l16 = lane & 15;
    const f32x4 wq0 = *(const f32x4*)(qw + l16 * 8), wq1 = *(const f32x4*)(qw + l16 * 8 + 4), wk0 = *(const f32x4*)(kw + l16 * 8), wk1 = *(const f32x4*)(kw + l16 * 8 + 4);
    for (int it0 = gw; it0 < 32768; it0 += 4 * NGW) {
        u32x4 raw[4]; bf16_t* pp[4]; bool kk[4];
#pragma unroll
        for (int q = 0; q < 4; ++q) { const int it = it0 + q * NGW; kk[q] = it >= 16384; pp[q] = (kk[q] ? K : Q) + ((size_t)((16384 * half + (it & 16383)) * 4 + sub)) * 128 + l16 * 8; raw[q] = (it < 32768) ? *(const u32x4*)pp[q] : (u32x4){0u, 0u, 0u, 0u}; }
#pragma unroll
        for (int q = 0; q < 4; ++q) { const int it = it0 + q * NGW;
            f32x4 a, bq; pg8::unpack8f(raw[q], a, bq);
            float ss = (a[0] * a[0] + a[1] * a[1]) + (a[2] * a[2] + a[3] * a[3]) + (bq[0] * bq[0] + bq[1] * bq[1]) + (bq[2] * bq[2] + bq[3] * bq[3]);
            ss += __shfl_xor(ss, 1); ss += __shfl_xor(ss, 2); ss += __shfl_xor(ss, 4); ss += __shfl_xor(ss, 8);
            const float rs = rsqrtf(ss * (1.0f / 128.0f) + 1e-6f);
            a = a * rs * (kk[q] ? wk0 : wq0); bq = bq * rs * (kk[q] ? wk1 : wq1);
            if (it < 32768) *(u32x4*)pp[q] = pg8::pack8f(a, bq); }
    }
}
template <int W>
__device__ __forceinline__ void pool_item(const bf16_t* U, bf16_t* G, int row0, int t0, int col0) {
    u32x4 rows[15 + W];
#pragma unroll
    for (int j = 0; j < 15 + W; ++j) { const int t = t0 - (W - 1) + j; rows[j] = (u32x4){0u, 0u, 0u, 0u}; if (t >= 0) rows[j] = *(const u32x4*)(U + (size_t)(row0 - (W - 1) + j) * DM + col0); }
    f32x4 s0 = {0.f, 0.f, 0.f, 0.f}, s1 = s0;
#pragma unroll
    for (int j = 0; j < W - 1; ++j) { f32x4 a, b; pg8::unpack8f(rows[j], a, b); s0 += a; s1 += b; }
#pragma unroll
    for (int i = 0; i < 16; ++i) { const int t = t0 + i;
        f32x4 a, b; pg8::unpack8f(rows[W - 1 + i], a, b); s0 += a; s1 += b;
        const float ic = 1.0f / (float)((t + 1) < W ? (t + 1) : W);
        *(u32x4*)(G + (size_t)(row0 + i) * DM + col0) = pg8::pack8f(s0 * ic - a, s1 * ic - b);
        f32x4 c, d; pg8::unpack8f(rows[i], c, d); s0 -= c; s1 -= d; }
}
__device__ __forceinline__ void pool_phase(const bf16_t* U, bf16_t* G, int i0, int i1, int istride) {
    for (int item = i0 + ltid(); item < i1; item += istride) {
        const int rb = item >> 8, ch = item & 255, col0 = ch * 8, grp = col0 >> 9, row0 = rb * 16, t0 = row0 & (SEQ - 1);
        if (grp == 0) pool_item<2>(U, G, row0, t0, col0); else if (grp == 1) pool_item<4>(U, G, row0, t0, col0); else if (grp == 2) pool_item<8>(U, G, row0, t0, col0); else pool_item<16>(U, G, row0, t0, col0);
    }
}
__device__ __forceinline__ att::BlockRef<att::bf16, att::bf16> att_ref(int bh, int qb, const bf16_t* Q, const bf16_t* K, const bf16_t* V, bf16_t* YZ, const bf16_t* SZI, const float* cs) {
    att::BlockRef<att::bf16, att::bf16> r; const int b = bh >> 4, hh = bh & 15;
    r.Q = (const att::bf16*)Q + ((size_t)bh * SEQ + (size_t)qb * 256) * 128; r.K = (const att::bf16*)K + (size_t)bh * SEQ * 128; r.V = (const att::bf16*)V + (size_t)bh * SEQ * 128;
    r.O = (att::bf16*)YZ + ((size_t)b * SEQ + (size_t)qb * 256) * DM + hh * 128; r.OI = (const att::bf16*)SZI + ((size_t)b * SEQ + (size_t)qb * 256) * DM + hh * 128; r.CS = cs + (size_t)bh * SEQ; r.P0 = qb * 256;
    return r;
}
__device__ __forceinline__ void attn_phase(att::lchar* lds, const bf16_t* Q, const bf16_t* K, const bf16_t* V, bf16_t* YZ, const bf16_t* SZI, float* cs, const float* flog, int L0, int total, int stride) {
    int L = L0; if (L >= total) return;
    { const int tid = ltid(), lane = tid & 63, wid = __builtin_amdgcn_readfirstlane(tid >> 6), seq = L >> 2, b = seq >> 4, hh = seq & 15;
      LAS float* red = (LAS float*)lds; float v[4];
#pragma unroll
      for (int i = 0; i < 4; ++i) v[i] = flog[((size_t)b * SEQ + 4 * tid + i) * 16 + hh];
      v[1] += v[0]; v[2] += v[1]; v[3] += v[2];
      float inc = v[3];
#pragma unroll
      for (int o = 1; o < 64; o <<= 1) { const float n = __shfl_up(inc, o); if (lane >= o) inc += n; }
      if (lane == 63) red[wid] = inc;
      __syncthreads();
      float base = 0.f;
      for (int w = 0; w < wid; ++w) base += red[w];
      const float ex = base + inc - v[3], inv = 11.313708498984761f;
      *(f32x4*)(cs + (size_t)seq * SEQ + 4 * tid) = (f32x4){(ex + v[0]) * inv, (ex + v[1]) * inv, (ex + v[2]) * inv, (ex + v[3]) * inv};
      asm volatile("s_waitcnt vmcnt(0)" ::: "memory");
      __syncthreads(); }
    int pass = 0;
    att::BlockRef<att::bf16, att::bf16> cur = att_ref(L >> 2, L & 3, Q, K, V, YZ, SZI, cs);
    att::Seam<att::bf16> S;
    att::causal_swa_prime<att::bf16, att::bf16>(cur, SEQ, lds, S);
    for (;;) {
        const bool more_pass = pass == 0, more_item = L + stride < total, last = !more_pass && !more_item;
        int passn = pass + 1, Ln = L;
        if (!more_pass) { passn = 0; Ln = more_item ? L + stride : L; }
        const int qbn = passn ? 7 - (Ln & 3) : (Ln & 3);
        const att::BlockRef<att::bf16, att::bf16> nxt = last ? cur : att_ref(Ln >> 2, qbn, Q, K, V, YZ, SZI, cs);
        att::causal_swa_block<att::bf16, att::bf16>(cur, nxt, SEQ, SEQ, lds, S);
        if (last) break;
        cur = nxt; pass = passn; L = Ln;
    }
}

#define XB_TMO      128
#define XB_XCNT(j)  (256  + 64 * (j))
#define XB_XSUB(j)  (1280 + 64 * (j))
#define XB_XGEN(j)  (2304 + 64 * (j))
#define XB_TOP      3328
#define XB_TOPGEN   3392
#define XCD_BAR_WORDS 3456
#define XB_SPIN_CAP (1u << 18)

__device__ __forceinline__ unsigned xb_ld(unsigned* p)              { return __hip_atomic_load(p, __ATOMIC_RELAXED, __HIP_MEMORY_SCOPE_AGENT); }
__device__ __forceinline__ unsigned xb_add(unsigned* p, unsigned v) { return __hip_atomic_fetch_add(p, v, __ATOMIC_RELAXED, __HIP_MEMORY_SCOPE_AGENT); }
__device__ __forceinline__ unsigned xb_xcc_id() { return (unsigned)__builtin_amdgcn_s_getreg((3 << 11) | 20) & 0xFu; }
#define XB_SPIN(cond, bar) do { unsigned _sp = 0; while (cond) { __builtin_amdgcn_s_sleep(1); \
    if ((++_sp & 255u) == 0u) { if (xb_ld(&(bar)[XB_TMO])) break; if (_sp > XB_SPIN_CAP) { atomicAdd(&(bar)[XB_TMO], 1u); break; } } } } while (0)

struct XcdBarrier {
    unsigned* bar; unsigned x; unsigned G;
    volatile LAS unsigned* st;
};

__device__ __forceinline__ XcdBarrier xcd_barrier_post(unsigned* bar, volatile LAS unsigned* st) {
    XcdBarrier b; b.bar = bar; b.x = xb_xcc_id(); b.st = st; b.G = 0;
    if (threadIdx.x == 0) (void)xb_add(&bar[XB_XCNT(b.x)], 1u);
    return b;
}
__device__ __forceinline__ void xcd_barrier_complete(unsigned* bar, unsigned x, unsigned& nloc, unsigned& nx, const unsigned G) {
    unsigned sum, cnt, mine, sp = 0u;
    for (;;) {
        sum = 0u; cnt = 0u; mine = 0u;
#pragma unroll
        for (unsigned j = 0; j < 16; ++j) { const unsigned c = xb_ld(&bar[XB_XCNT(j)]); sum += c; cnt += (c > 0u) ? 1u : 0u; mine = (j == x) ? c : mine; }
        if (sum == G) break;
        __builtin_amdgcn_s_sleep(1);
        if ((++sp & 255u) == 0u) { if (xb_ld(&bar[XB_TMO])) break; if (sp > XB_SPIN_CAP) { atomicAdd(&bar[XB_TMO], 1u); break; } }
    }
    nloc = mine > 0u ? mine : 1u; nx = cnt > 0u ? cnt : 1u;
}

__device__ __forceinline__ void xcd_barrier(const XcdBarrier& b) {
    asm volatile("s_waitcnt vmcnt(0)" ::: "memory");
    __syncthreads();
    if (threadIdx.x == 0) {
        unsigned* bar = b.bar;
        __builtin_amdgcn_s_waitcnt(0);
        unsigned nloc = b.st[0], nx = b.st[1];
        if (nloc == 0u) { xcd_barrier_complete(bar, b.x, nloc, nx, b.G); b.st[0] = nloc; b.st[1] = nx; }
        const unsigned old = xb_add(&bar[XB_XSUB(b.x)], 1u);
        const unsigned gen = old / nloc;
        if (old + 1u == (gen + 1u) * nloc) {
            __builtin_amdgcn_fence(__ATOMIC_RELEASE, "agent");
            asm volatile("s_waitcnt vmcnt(0)" ::: "memory");
            const unsigned og = xb_add(&bar[XB_TOP], 1u);
            const unsigned tg = og / nx;
            if (og + 1u == (tg + 1u) * nx) xb_add(&bar[XB_TOPGEN], 1u);
            else XB_SPIN(xb_ld(&bar[XB_TOPGEN]) == tg, bar);
            __builtin_amdgcn_fence(__ATOMIC_ACQUIRE, "agent");
            xb_add(&bar[XB_XGEN(b.x)], 1u);
            asm volatile("s_waitcnt vmcnt(0)" ::: "memory");
        } else {
            XB_SPIN(xb_ld(&bar[XB_XGEN(b.x)]) == gen, bar);
            __builtin_amdgcn_fence(__ATOMIC_ACQUIRE, "agent");
            asm volatile("s_waitcnt vmcnt(0)" ::: "memory");
        }
    }
    __syncthreads();
}

template <class T> __device__ __forceinline__ T* asglobal(T* p) { return (T*)(__attribute__((address_space(1))) T*)p; }
typedef const __attribute__((address_space(4))) Params* KArgs;
#define PIN(i) asglobal(Pk->in[i])
#define WSP(T, off) ((T*)(ws + (off)))
__global__ void __launch_bounds__(512, 2) mega(Params P) {
    extern __shared__ __attribute__((aligned(16))) unsigned char lds[];
    cg::grid_group grid = cg::this_grid();
    volatile LAS unsigned* bst = (volatile LAS unsigned*)((LAS unsigned char*)lds + LDS_BYTES - 64);
    if (threadIdx.x < 4) bst[threadIdx.x] = 0u;
    __syncthreads();
    const int half = lbid() >> 7, vb = lbid() & 127, vg = 128;
    { unsigned* bw = (unsigned*)(P.ws + WS_MISC + MS_BAR); for (int i = blockIdx.x * 512 + threadIdx.x; i < (int)(BAR_BYTES / 4); i += gridDim.x * 512) bw[i] = 0u; }
    grid.sync();
    (void)xcd_barrier_post((unsigned*)(P.ws + WS_MISC + MS_BAR), bst);
    (void)xcd_barrier_post((unsigned*)(P.ws + WS_MISC + MS_BAR) + (1 + (blockIdx.x >> 7)) * XCD_BAR_WORDS, bst + 2);
#define XBAR_G() do { XcdBarrier xb_; xb_.bar = (unsigned*)(asglobal(((KArgs)__builtin_amdgcn_kernarg_segment_ptr())->ws) + WS_MISC + MS_BAR); xb_.x = xb_xcc_id(); xb_.st = bst; xb_.G = 256u; xcd_barrier(xb_); } while (0)
#define XBAR_H() do { XcdBarrier xb_; xb_.bar = (unsigned*)(asglobal(((KArgs)__builtin_amdgcn_kernarg_segment_ptr())->ws) + WS_MISC + MS_BAR) + (1 + half) * XCD_BAR_WORDS; xb_.x = xb_xcc_id(); xb_.st = bst + 2; xb_.G = 128u; xcd_barrier(xb_); } while (0)
    { KArgs Pk = (KArgs)__builtin_amdgcn_kernarg_segment_ptr(); asm volatile("" : "+s"(Pk)); prologue(Pk, (LAS unsigned char*)lds); }
    XBAR_G();
    if (half) { KArgs Pk = (KArgs)__builtin_amdgcn_kernarg_segment_ptr(); asm volatile("" : "+s"(Pk)); convert_rest(Pk, (LAS unsigned char*)lds, 6272, 12544, vb, vg); __syncthreads(); }
    for (int ph = 1; ph < NPHASE; ++ph) {
        KArgs Pk = (KArgs)__builtin_amdgcn_kernarg_segment_ptr(); asm volatile("" : "+s"(Pk));
        unsigned char* ws = asglobal(Pk->ws);
        const int layer = (ph - 1) >> 2, sub = (ph - 1) & 3;
        const int kind = layer % 3, j = layer / 3;
        if (sub == 1) {
            if (kind == 0) s5_phase((LAS unsigned char*)lds, WSP(bf16_t, WS_U), WSP(bf16_t, WS_K), WSP(float, WS_MISC + MS_ABAR) + (size_t)j * 128 * 64 * 2, WSP(bf16_t, WS_MISC + MS_BBAR) + (size_t)j * 128 * 128 * 16,
                                    WSP(bf16_t, WS_MISC + MS_CM) + (size_t)j * 128 * 16 * 128, PIN(11) + j * DM, 128 * half + vb, 128 * half + 128, vg);
            else if (kind == 1) {   }
            else pool_phase(WSP(bf16_t, WS_U), WSP(bf16_t, WS_K), 65536 * half + vb * 512, 65536 * half + 65536, vg * 512);
        } else if (sub == 2 && kind == 1) {
            attn_phase((att::lchar*)lds, WSP(bf16_t, WS_U), WSP(bf16_t, WS_K), WSP(bf16_t, WS_V), WSP(bf16_t, WS_SZ), WSP(bf16_t, WS_SZ), WSP(float, WS_MISC + MS_CS), WSP(float, WS_MISC + MS_FLOG), 128 * half + vb, 128 * half + 128, vg);
        } else {
            const bf16_t* gA; const bf16_t* gB; int gN = DM, gK = DM, ggrp = 0, emode;
            const float* e_ssq = nullptr; const bf16_t* e_g = nullptr; const float* e_vec = nullptr; const float* e_hin = nullptr; bf16_t* e_hb = nullptr; float* e_ssqo = nullptr; float* e_hout = nullptr;
            float* ssq = WSP(float, WS_MISC + MS_SSQ);
            if (sub == 0) {
                gA = WSP(bf16_t, WS_HB); e_ssq = ssq + (size_t)layer * MTOK * 8;
                if (kind == 0) { gB = WSP(bf16_t, WS_W_S5IN) + (size_t)j * 4096 * 2048; gN = 4096; emode = pg8::EM_UZ; }
                else if (kind == 1) { gB = WSP(bf16_t, WS_W_FOXIN); gN = 8192; emode = pg8::EM_QKVZ; }
                else { gB = WSP(bf16_t, WS_W_POOLIN); gN = 4096; emode = pg8::EM_UZ; }
            } else if (sub == 2) {
                gA = WSP(bf16_t, WS_K); e_g = gA;
                if (kind == 0) { gB = WSP(bf16_t, WS_W_GLU) + (size_t)j * 2048 * 2048; emode = pg8::EM_GLU; e_vec = PIN(13) + j * DM; }
                else { gB = WSP(bf16_t, WS_W_POOLG); gK = 512; ggrp = 2; emode = pg8::EM_POOL; e_vec = PIN(20); }
            } else {
                gA = WSP(bf16_t, WS_SZ); gB = WSP(bf16_t, WS_W_OUT) + (size_t)layer * 2048 * 2048; emode = pg8::EM_OUT;
                e_hin = layer == 0 ? PIN(0) : (const float*)asglobal(Pk->out); e_hout = asglobal(Pk->out);
                e_hb = layer < 3 ? WSP(bf16_t, WS_HB) : nullptr; e_ssqo = layer < 3 ? ssq + (size_t)(layer + 1) * MTOK * 8 : nullptr;
            }
            { const pg8::Gemm g{gA, gB, MTOK / 2, gN, gK, DM, ggrp};
              const pg8::Epi E{(PG8_LAS float*)((PG8_LAS unsigned char*)lds + 131072), PIN(15), PIN(16), emode, (emode == pg8::EM_OUT || (DRAIN_ALL && emode >= pg8::EM_GLU)) ? 1 : 0, e_ssq, WSP(bf16_t, WS_U), WSP(bf16_t, WS_SZ), WSP(bf16_t, WS_SZ), e_g, e_vec, e_hin, nullptr, nullptr, e_hout, e_hb, nullptr, e_ssqo};
              pg8::StaticOrder S; S.init(MTOK / 2, gN, vg, vb, 16 * half);
              pg8::gemm_phase<pg8::Epi, pg8::StaticOrder, true, true>((PG8_LAS unsigned char*)lds, g, S, E); }
            if (sub == 0 && kind == 1) { __syncthreads();
                flog_phase((LAS unsigned char*)lds, WSP(bf16_t, WS_HB), ssq + (size_t)layer * MTOK * 8, WSP(bf16_t, WS_MISC + MS_WF), PIN(17), WSP(float, WS_MISC + MS_FLOG), 128 * half + vb, 128 * half + 128, vg); }
        }
        if (ph == 4) { if (!half) { convert_rest(Pk, (LAS unsigned char*)lds, 0, 6272, vb, vg); } XBAR_G(); }
        else if (ph + 1 < NPHASE && !(sub == 1 && kind == 1)) XBAR_H();
    }
}
}

extern "C" void kernel_launch(void* const* d_in, const int* in_sizes, int n_in, void* d_out, int out_size, void* d_ws, size_t ws_size, hipStream_t stream) {
    static int grid = 0;
    if (grid == 0) {
        if (n_in != 21 || out_size != mk::MTOK * mk::DM || ws_size < mk::WS_END) { fprintf(stderr, "kernel_launch: unexpected problem (n_in %d, out %d, ws %zu < %zu)\n", n_in, out_size, ws_size, (size_t)mk::WS_END); grid = -1; return; }
        int dev = 0, cus = 0, per_cu = 0;
        if (hipGetDevice(&dev) != hipSuccess || hipDeviceGetAttribute(&cus, hipDeviceAttributeMultiprocessorCount, dev) != hipSuccess) { grid = -1; return; }
        if (hipFuncSetAttribute((const void*)mk::mega, hipFuncAttributeMaxDynamicSharedMemorySize, mk::LDS_BYTES) != hipSuccess) { fprintf(stderr, "kernel_launch: hipFuncSetAttribute failed\n"); grid = -1; return; }
        if (hipOccupancyMaxActiveBlocksPerMultiprocessor(&per_cu, (const void*)mk::mega, 512, mk::LDS_BYTES) != hipSuccess || per_cu < 1) { fprintf(stderr, "kernel_launch: occupancy query says %d blocks per CU\n", per_cu); grid = -1; return; }
        grid = cus * per_cu;
        if (grid != 256) { fprintf(stderr, "kernel_launch: this build splits the grid into two halves of 128 workgroups and needs exactly 256 (got %d)\n", grid); grid = -1; return; }
    }
    if (grid < 0) return;
    mk::Params p{};
    for (int i = 0; i < 21; ++i) p.in[i] = (const float*)d_in[i];
    p.out = (float*)d_out; p.ws = (unsigned char*)d_ws;
    p.ph_lo = 0; p.ph_hi = mk::NPHASE; void* args[] = {&p};
    hipError_t e = hipLaunchCooperativeKernel((const void*)mk::mega, dim3(grid), dim3(512), args, mk::LDS_BYTES, stream);
    if (e != hipSuccess) fprintf(stderr, "kernel_launch: cooperative launch failed: %s (grid %d)\n", hipGetErrorString(e), grid);
}
```
